# Optimizing an MI355X kernel written in HIP

```python
import math
import jax, jax.numpy as jnp
from jax import lax
import numpy as np

D_MODEL = 1024
BATCH = 16
SEQ = 256
DEPTH = 4
DEC_BATCH = 4
DEC_SEQ = 2048
PAST_LEN = 512

GRID_W = 64
HEAD_DIM = 64
GROUP_W = D_MODEL // 4
N_HEADS_GRP = GROUP_W // HEAD_DIM
DA_SUB = HEAD_DIM // 2
CONV_K = 3
MLA_Q_RANK = 256
MLA_KV_RANK = 128
MLA_NOPE = 64
MLA_ROPE = 32
MLA_V = 64
MLA_SCALE = (MLA_NOPE + MLA_ROPE) ** -0.5
NA_WIN_H = 8
NA_WIN_W = 16
NA_COL_BLOCK = 16
NA_BAND_W = 2 * NA_WIN_W
ROPE_BASE = 10000.0
Q_BLOCK = 128
EPS = 1e-6
NEG_INF = -1e30
IN_SIZES = (GROUP_W,) * 8 + (MLA_Q_RANK, MLA_KV_RANK, MLA_ROPE, GROUP_W) + (GROUP_W,) * 4
D_IN = sum(IN_SIZES)

kernel_name = 'hybrid_parallel_groups_flow_step'


def rms_norm(x, g):
    xf = x.astype(jnp.float32)
    y = xf * lax.rsqrt(jnp.mean(xf * xf, axis=-1, keepdims=True) + EPS)
    return (y * g.astype(jnp.float32)).astype(x.dtype)


def adaln(cvec, w, b):
    m = jax.nn.silu(cvec) @ w + b
    return jnp.split(m, 3, axis=-1)


def in_projection(x, shift, scale, norm_g, w_in):
    h = rms_norm(x, norm_g) * (1.0 + scale) + shift
    u = h @ w_in
    parts, off = [], 0
    for n in IN_SIZES:
        parts.append(u[..., off:off + n])
        off += n
    return parts


def out_projection(ys, zs, w_out):
    y = jnp.concatenate([yb * jax.nn.silu(z) for yb, z in zip(ys, zs)], axis=-1)
    return y @ w_out


def axial_rope_tables(T, rot_dim):
    t = jnp.arange(T)
    rows = (t // GRID_W).astype(jnp.float32)
    cols = (t % GRID_W).astype(jnp.float32)
    half = rot_dim // 2
    inv = 1.0 / (ROPE_BASE ** (jnp.arange(0, half, 2, dtype=jnp.float32) / half))
    ar = rows[:, None] * inv
    ac = cols[:, None] * inv
    ang = jnp.concatenate([ar, ar, ac, ac], axis=-1)
    return jnp.cos(ang), jnp.sin(ang)


def apply_axial_rope(x, cos, sin):
    T, R = cos.shape
    q4 = R // 4
    xs = x.reshape(*x.shape[:-1], 2, 2, q4)
    rot = jnp.stack([-xs[..., 1, :], xs[..., 0, :]], axis=-2).reshape(x.shape)
    bshape = (1, T) + (1,) * (x.ndim - 3) + (R,)
    out = x.astype(jnp.float32) * cos.reshape(bshape) + rot.astype(jnp.float32) * sin.reshape(bshape)
    return out.astype(x.dtype)


def map_query_blocks(fn, *qs):
    bsz, S = qs[0].shape[:2]
    nb = S // Q_BLOCK
    blocks = tuple(jnp.swapaxes(q.reshape(bsz, nb, Q_BLOCK, *q.shape[2:]), 0, 1) for q in qs)
    out = lax.map(lambda blk: fn(*blk), blocks)
    out = jnp.swapaxes(out, 0, 1)
    return out.reshape(bsz, S, *out.shape[3:])


def dense_attend(q, k, v, scale):
    s = jnp.einsum('bqhd,bkhd->bhqk', q, k).astype(jnp.float32) * scale
    p = jax.nn.softmax(s, axis=-1)
    return jnp.einsum('bhqk,bkhe->bqhe', p.astype(v.dtype), v)


def diff_lambda(lam_vecs, lam_init):
    lv = lam_vecs.astype(jnp.float32)
    return jnp.exp(jnp.sum(lv[0] * lv[1])) - jnp.exp(jnp.sum(lv[2] * lv[3])) + lam_init


def diff_attend(q, k, v, lam, lam_init, subln_g):
    s = jnp.einsum('bqhcd,bkhcd->bchqk', q, k).astype(jnp.float32) * (DA_SUB ** -0.5)
    p = jax.nn.softmax(s, axis=-1)
    attn = p[:, 0] - lam * p[:, 1]
    o = jnp.einsum('bhqk,bkhe->bqhe', attn.astype(v.dtype), v)
    return rms_norm(o, subln_g) * (1.0 - lam_init)


def short_conv(u, w):
    return lax.conv_general_dilated(
        u, w[:, None, :], window_strides=(1,), padding=[(CONV_K // 2, CONV_K // 2)],
        dimension_numbers=('NWC', 'WIO', 'NWC'), feature_group_count=u.shape[-1])


def mla_compress(cq, ckv, p):
    bsz, T = cq.shape[:2]
    q = (rms_norm(cq, p['mla_q_norm_g']) @ p['mla_w_uq']).reshape(bsz, T, N_HEADS_GRP, MLA_NOPE + MLA_ROPE)
    return q[..., :MLA_NOPE], q[..., MLA_NOPE:], rms_norm(ckv, p['mla_kv_norm_g'])


def mla_expand(ckv_n, w_ukv):
    bsz, K = ckv_n.shape[:2]
    kv = (ckv_n @ w_ukv).reshape(bsz, K, N_HEADS_GRP, MLA_NOPE + MLA_V)
    return kv[..., :MLA_NOPE], kv[..., MLA_NOPE:]


def mla_attend(qn, qp, kn, kp, v):
    s = (jnp.einsum('bqhd,bkhd->bhqk', qn, kn)
         + jnp.einsum('bqhr,bkr->bhqk', qp, kp)).astype(jnp.float32) * MLA_SCALE
    p = jax.nn.softmax(s, axis=-1)
    return jnp.einsum('bhqk,bkhe->bqhe', p.astype(v.dtype), v)


def neighbourhood_attend(q, k, v, ctx_k, ctx_v, rpb):
    bsz, T, H, d = q.shape
    rows = T // GRID_W
    wr = min(NA_WIN_H, rows)
    ncb = GRID_W // NA_COL_BLOCK
    r = np.arange(rows)
    row_idx = np.clip(r - wr // 2, 0, rows - wr)[:, None] + np.arange(wr)
    j = np.arange(ncb)
    band_start = np.clip(j * NA_COL_BLOCK - NA_WIN_W // 2, 0, GRID_W - NA_BAND_W)
    col_idx = band_start[:, None] + np.arange(NA_BAND_W)
    qcol = j[:, None] * NA_COL_BLOCK + np.arange(NA_COL_BLOCK)
    win_start = np.clip(qcol - NA_WIN_W // 2, 0, GRID_W - NA_WIN_W)
    col_mask = ((col_idx[:, None, :] >= win_start[:, :, None])
                & (col_idx[:, None, :] < win_start[:, :, None] + NA_WIN_W))
    dy = row_idx - r[:, None] + NA_WIN_H - 1
    dx = np.clip(col_idx[:, None, :] - qcol[:, :, None] + NA_WIN_W - 1, 0, 2 * NA_WIN_W - 2)
    bias = rpb[:, dy[:, None, None, :, None], dx[None, :, :, None, :]].astype(jnp.float32)
    bias = jnp.where(col_mask[None, None, :, :, None, :], bias, NEG_INF)
    bias = bias.transpose(1, 2, 0, 3, 4, 5).reshape(rows, ncb, H, NA_COL_BLOCK, wr * NA_BAND_W)

    qg = q.reshape(bsz, rows, ncb, NA_COL_BLOCK, H, d)
    ri = row_idx[:, None, :, None]
    ci = col_idx[None, :, None, :]

    def gather_band(a):
        g = a.reshape(bsz, rows, GRID_W, H, d)[:, ri, ci]
        return g.transpose(0, 1, 2, 5, 3, 4, 6).reshape(bsz, rows, ncb, H, wr * NA_BAND_W, d)

    kb = gather_band(k)
    vb = gather_band(v)
    scale = d ** -0.5
    s_loc = jnp.einsum('brjqhd,brjhkd->brjhqk', qg, kb).astype(jnp.float32) * scale + bias[None]
    s_ctx = jnp.einsum('brjqhd,blhd->brjhql', qg, ctx_k).astype(jnp.float32) * scale
    p = jax.nn.softmax(jnp.concatenate([s_loc, s_ctx], axis=-1), axis=-1)
    k_loc = wr * NA_BAND_W
    o = (jnp.einsum('brjhqk,brjhkd->brjqhd', p[..., :k_loc].astype(v.dtype), vb)
         + jnp.einsum('brjhql,blhd->brjqhd', p[..., k_loc:].astype(v.dtype), ctx_v))
    return o.reshape(bsz, T, H, d)


def context_layer(x, mod, p, lam_init):
    bsz, L, _ = x.shape
    H = N_HEADS_GRP
    shift, scale, gate = mod
    (aq, ak, av, az, bb, bc, bh, bz, cq, ckv, ckpe, cz, dq, dk, dv, dz) = in_projection(
        x, shift, scale, p['norm_g'], p['w_in'])
    aq = aq.reshape(bsz, L, H, 2, DA_SUB)
    ak = ak.reshape(bsz, L, H, 2, DA_SUB)
    av = av.reshape(bsz, L, H, HEAD_DIM)
    lam = diff_lambda(p['da_lambda'], lam_init)
    ya = map_query_blocks(lambda qb: diff_attend(qb, ak, av, lam, lam_init, p['da_subln_g']), aq)
    yb = bb * short_conv(bc * bh, p['conv_w'])
    qn, qp, ckv_n = mla_compress(cq, ckv, p)
    kn, vc = mla_expand(ckv_n, p['mla_w_ukv'])
    yc = map_query_blocks(lambda a, b: mla_attend(a, b, kn, ckpe, vc), qn, qp)
    dq = dq.reshape(bsz, L, H, HEAD_DIM)
    dk = dk.reshape(bsz, L, H, HEAD_DIM)
    dv = dv.reshape(bsz, L, H, HEAD_DIM)
    yd = map_query_blocks(lambda qb: dense_attend(qb, dk, dv, HEAD_DIM ** -0.5), dq)
    y = out_projection([ya.reshape(bsz, L, GROUP_W), yb, yc.reshape(bsz, L, GROUP_W), yd.reshape(bsz, L, GROUP_W)],
                       [az, bz, cz, dz], p['w_out'])
    x = x + gate * y
    return x, (ak.reshape(bsz, L, H, HEAD_DIM), av, ckv_n, ckpe, dk, dv)


def latent_layer(x, mod, p, lam_init, ctx):
    bsz, T, _ = x.shape
    H = N_HEADS_GRP
    ctx_ak, ctx_av, ctx_ckv, ctx_kpe, ctx_dk, ctx_dv = ctx
    L = ctx_ak.shape[1]
    shift, scale, gate = mod
    (aq, ak, av, az, bb, bc, bh, bz, cq, ckv, ckpe, cz, dq, dk, dv, dz) = in_projection(
        x, shift, scale, p['norm_g'], p['w_in'])
    cos_a, sin_a = axial_rope_tables(T, DA_SUB)
    aq = apply_axial_rope(aq.reshape(bsz, T, H, 2, DA_SUB), cos_a, sin_a)
    ak = apply_axial_rope(ak.reshape(bsz, T, H, 2, DA_SUB), cos_a, sin_a)
    k_all = jnp.concatenate([ctx_ak.reshape(bsz, L, H, 2, DA_SUB), ak], axis=1)
    v_all = jnp.concatenate([ctx_av, av.reshape(bsz, T, H, HEAD_DIM)], axis=1)
    lam = diff_lambda(p['da_lambda'], lam_init)
    ya = map_query_blocks(lambda qb: diff_attend(qb, k_all, v_all, lam, lam_init, p['da_subln_g']), aq)
    yb = bb * short_conv(bc * bh, p['conv_w'])
    cos_c, sin_c = axial_rope_tables(T, MLA_ROPE)
    qn, qp, ckv_n = mla_compress(cq, ckv, p)
    qp = apply_axial_rope(qp, cos_c, sin_c)
    kp_all = jnp.concatenate([ctx_kpe, apply_axial_rope(ckpe, cos_c, sin_c)], axis=1)
    kn, vc = mla_expand(jnp.concatenate([ctx_ckv, ckv_n], axis=1), p['mla_w_ukv'])
    yc = map_query_blocks(lambda a, b: mla_attend(a, b, kn, kp_all, vc), qn, qp)
    yd = neighbourhood_attend(dq.reshape(bsz, T, H, HEAD_DIM), dk.reshape(bsz, T, H, HEAD_DIM),
                              dv.reshape(bsz, T, H, HEAD_DIM), ctx_dk, ctx_dv, p['na_rpb'])
    y = out_projection([ya.reshape(bsz, T, GROUP_W), yb, yc.reshape(bsz, T, GROUP_W), yd.reshape(bsz, T, GROUP_W)],
                       [az, bz, cz, dz], p['w_out'])
    return x + gate * y


def setup_inputs(seed: int = 0) -> dict:
    key = jax.random.key(seed)
    ks = jax.random.split(key, 24)
    H = N_HEADS_GRP

    def nrm(k, shape, s):
        return jax.random.normal(k, shape, jnp.float32) * s

    return {
        'x_prompt': nrm(ks[0], (BATCH, SEQ, D_MODEL), 1.0),
        'x_sample': nrm(ks[1], (DEC_BATCH, DEC_SEQ, D_MODEL), 1.0),
        'cache_a_k': nrm(ks[2], (DEC_BATCH, DEPTH, PAST_LEN, H, HEAD_DIM), 1.0),
        'cache_a_v': nrm(ks[3], (DEC_BATCH, DEPTH, PAST_LEN, H, HEAD_DIM), 1.0),
        'cache_c_kv': nrm(ks[4], (DEC_BATCH, DEPTH, PAST_LEN, MLA_KV_RANK), 1.0),
        'cache_c_kpe': nrm(ks[5], (DEC_BATCH, DEPTH, PAST_LEN, MLA_ROPE), 1.0),
        'cache_d_k': nrm(ks[6], (DEC_BATCH, DEPTH, PAST_LEN, H, HEAD_DIM), 1.0),
        'cache_d_v': nrm(ks[7], (DEC_BATCH, DEPTH, PAST_LEN, H, HEAD_DIM), 1.0),
        'c': nrm(ks[8], (DEC_BATCH, D_MODEL), 1.0),
        'c_ctx': nrm(ks[9], (D_MODEL,), 1.0),
        'ada_w': nrm(ks[10], (DEPTH, D_MODEL, 3 * D_MODEL), 0.5 * D_MODEL ** -0.5),
        'ada_b': nrm(ks[11], (DEPTH, 3 * D_MODEL), 0.01),
        'norm_g': 1.0 + nrm(ks[12], (DEPTH, D_MODEL), 0.05),
        'w_in': nrm(ks[13], (DEPTH, D_MODEL, D_IN), D_MODEL ** -0.5),
        'da_lambda': nrm(ks[14], (DEPTH, 4, DA_SUB), 0.1),
        'da_subln_g': 1.0 + nrm(ks[15], (DEPTH, HEAD_DIM), 0.05),
        'conv_w': nrm(ks[16], (DEPTH, CONV_K, GROUP_W), CONV_K ** -0.5),
        'mla_q_norm_g': 1.0 + nrm(ks[17], (DEPTH, MLA_Q_RANK), 0.05),
        'mla_w_uq': nrm(ks[18], (DEPTH, MLA_Q_RANK, H * (MLA_NOPE + MLA_ROPE)), MLA_Q_RANK ** -0.5),
        'mla_kv_norm_g': 1.0 + nrm(ks[19], (DEPTH, MLA_KV_RANK), 0.05),
        'mla_w_ukv': nrm(ks[20], (DEPTH, MLA_KV_RANK, H * (MLA_NOPE + MLA_V)), MLA_KV_RANK ** -0.5),
        'na_rpb': nrm(ks[21], (DEPTH, H, 2 * NA_WIN_H - 1, 2 * NA_WIN_W - 1), 0.1),
        'w_out': nrm(ks[22], (DEPTH, D_MODEL, D_MODEL), D_MODEL ** -0.5),
        'final_norm_g': 1.0 + nrm(ks[23], (D_MODEL,), 0.05),
    }


def reference(x_prompt, x_sample, cache_a_k, cache_a_v, cache_c_kv, cache_c_kpe, cache_d_k, cache_d_v,
              c, c_ctx, ada_w, ada_b, norm_g, w_in, da_lambda, da_subln_g, conv_w,
              mla_q_norm_g, mla_w_uq, mla_kv_norm_g, mla_w_ukv, na_rpb, w_out, final_norm_g):
    xp = x_prompt
    xs = x_sample
    s_ak, s_av, s_ckv, s_kpe, s_dk, s_dv = [], [], [], [], [], []
    for l in range(DEPTH):
        p = {
            'norm_g': norm_g[l], 'w_in': w_in[l], 'da_lambda': da_lambda[l], 'da_subln_g': da_subln_g[l],
            'conv_w': conv_w[l], 'mla_q_norm_g': mla_q_norm_g[l], 'mla_w_uq': mla_w_uq[l],
            'mla_kv_norm_g': mla_kv_norm_g[l], 'mla_w_ukv': mla_w_ukv[l], 'na_rpb': na_rpb[l],
            'w_out': w_out[l],
        }
        lam_init = 0.8 - 0.6 * math.exp(-0.3 * l)
        mod_ctx = adaln(c_ctx, ada_w[l], ada_b[l])
        xp, (ak, av, ckv_n, kpe, dk, dv) = context_layer(xp, mod_ctx, p, lam_init)
        s_ak.append(ak); s_av.append(av); s_ckv.append(ckv_n)
        s_kpe.append(kpe); s_dk.append(dk); s_dv.append(dv)
        shift, scale, gate = adaln(c, ada_w[l], ada_b[l])
        mod_lat = (shift[:, None, :], scale[:, None, :], gate[:, None, :])
        ctx_l = (cache_a_k[:, l], cache_a_v[:, l], cache_c_kv[:, l], cache_c_kpe[:, l],
                 cache_d_k[:, l], cache_d_v[:, l])
        xs = latent_layer(xs, mod_lat, p, lam_init, ctx_l)
    y_prompt = rms_norm(xp, final_norm_g)
    y_sample = rms_norm(xs, final_norm_g)
    state_a_k = jnp.stack(s_ak, axis=1)
    state_a_v = jnp.stack(s_av, axis=1)
    state_c_kv = jnp.stack(s_ckv, axis=1)
    state_c_kpe = jnp.stack(s_kpe, axis=1)
    state_d_k = jnp.stack(s_dk, axis=1)
    state_d_v = jnp.stack(s_dv, axis=1)
    return (y_prompt, y_sample, state_a_k, state_a_v, state_c_kv, state_c_kpe, state_d_k, state_d_v)
```

```cpp
#include <hip/hip_runtime.h>
#include <hip/hip_cooperative_groups.h>
#include <stdint.h>
#include <stdio.h>
namespace cg = cooperative_groups;

#ifndef MEGA
#define MEGA 0
#endif

#define DI __device__ __forceinline__
#define LAS __attribute__((address_space(3)))
#define GAS __attribute__((address_space(1)))
typedef unsigned short bf16_t;
typedef short bf16x8 __attribute__((ext_vector_type(8)));
typedef short s16x4 __attribute__((ext_vector_type(4)));
typedef float f32x16 __attribute__((ext_vector_type(16)));
typedef float f32x4 __attribute__((ext_vector_type(4)));
typedef float f32x2 __attribute__((ext_vector_type(2)));
typedef unsigned u32x4 __attribute__((ext_vector_type(4)));
typedef unsigned u32x2 __attribute__((ext_vector_type(2)));
typedef __bf16 bf16v2 __attribute__((ext_vector_type(2)));

constexpr int DM = 1024, NCTX = 4096, NLAT = 8192, NTOK = 12288, DEPTH = 4;
constexpr int USTR = 3744;
constexpr int NPADW = 3840;
constexpr int U_AQ = 0, U_AK = 256, U_AV = 512, U_AZ = 768, U_BB = 1024, U_BC = 1280, U_BH = 1536, U_BZ = 1792,
              U_CQ = 2048, U_CKV = 2304, U_CZ = 2432, U_DQ = 2688, U_DK = 2944, U_DV = 3200, U_DZ = 3456, U_KPE = 3712;
constexpr int KCS = 640;
constexpr float LOG2E = 1.4426950408889634f, EPS = 1e-6f;
constexpr float SC_A = 0.17677669529663687f * LOG2E;
constexpr float SC_C = 0.10206207261596575f * LOG2E;
constexpr float SC_D = 0.125f * LOG2E;
constexpr float NEGBIG = -1e30f;

constexpr size_t O_YP = 0, O_YS = 4194304, O_SAK = 12582912, O_SAV = 16777216, O_SCKV = 20971520, O_SKPE = 23068672,
                 O_SDK = 23592960, O_SDV = 27787264;

constexpr size_t WS_CTL = 0;
constexpr size_t WS_MOD = 65536;
constexpr size_t WS_ROPE = WS_MOD + 4 * 5 * 3072 * 4;
constexpr size_t WS_LAM = WS_ROPE + 64 * 16 * 4;
constexpr size_t WS_SSQ = WS_LAM + 256;
constexpr size_t WS_WIN = WS_SSQ + (size_t)NTOK * 8 * 4;
constexpr size_t WS_WOUT = WS_WIN + (size_t)4 * NPADW * 1024 * 2;
constexpr size_t WS_WUQ = WS_WOUT + (size_t)4 * 1024 * 1024 * 2;
constexpr size_t WS_WUKV = WS_WUQ + (size_t)4 * 384 * 256 * 2;
constexpr size_t WS_CAK = WS_WUKV + (size_t)4 * 512 * 128 * 2;
constexpr size_t WS_CAV = WS_CAK + 4194304;
constexpr size_t WS_CDK = WS_CAV + 4194304;
constexpr size_t WS_CDV = WS_CDK + 4194304;
constexpr size_t WS_CKVC = WS_CDV + 4194304;
constexpr size_t WS_KCC = WS_CKVC + 2097152;
constexpr size_t WS_H = WS_KCC + (size_t)4 * 4 * 512 * KCS * 2;
constexpr size_t WS_U = WS_H + (size_t)NTOK * 1024 * 2;
constexpr size_t WS_KC = WS_U + (size_t)NTOK * USTR * 2;
constexpr size_t WS_QC = WS_KC + (size_t)NTOK * KCS * 2;
constexpr size_t WS_YG = WS_QC + (size_t)NTOK * 384 * 2;
constexpr size_t WS_END = WS_YG + (size_t)NTOK * 1024 * 2;
static_assert(WS_END <= (size_t)256 * 1024 * 1024, "workspace map exceeds 256 MiB");
static_assert(WS_WIN % 256 == 0 && WS_U % 256 == 0 && WS_KC % 256 == 0 && WS_QC % 256 == 0 && WS_YG % 256 == 0 && WS_H % 256 == 0, "align");

constexpr int LDS_BYTES = 65536 + 64;
constexpr int LDS_CTLOFF = 65536;
constexpr int NPHASE = 22;
constexpr int CW_QUEUE = 64;

struct Params {
    const float* in[24];
    float* out;
    unsigned char* ws;
    int ph_lo, ph_hi;
};

DI int tidx() { int t = threadIdx.x; asm volatile("" : "+v"(t)); return t; }
DI float bf2f(unsigned b) { return __uint_as_float(b << 16); }
DI unsigned pk2(float lo, float hi) { f32x2 v = {lo, hi}; bf16v2 b = __builtin_convertvector(v, bf16v2); return __builtin_bit_cast(unsigned, b); }
DI float wave_sum(float v) {
#pragma unroll
    for (int o = 32; o >= 1; o >>= 1) v += __shfl_xor(v, o);
    return v;
}
DI float half_swap_max(float v) {
    auto rr = __builtin_amdgcn_permlane32_swap(__float_as_uint(v), __float_as_uint(v), false, false);
    return fmaxf(__uint_as_float(rr[0]), __uint_as_float(rr[1]));
}
DI float half_swap_sum(float v) {
    auto rr = __builtin_amdgcn_permlane32_swap(__float_as_uint(v), __float_as_uint(v), false, false);
    return __uint_as_float(rr[0]) + __uint_as_float(rr[1]);
}
DI int crow(int i, int hh) { return (i & 3) + 8 * (i >> 2) + 4 * hh; }
DI float siluf(float x) { return x / (1.f + __expf(-x)); }
DI void store_bf16x32(bf16_t* dst, const float* v) {
#pragma unroll
    for (int q = 0; q < 4; ++q) {
        u32x4 w = {pk2(v[8 * q], v[8 * q + 1]), pk2(v[8 * q + 2], v[8 * q + 3]), pk2(v[8 * q + 4], v[8 * q + 5]), pk2(v[8 * q + 6], v[8 * q + 7])};
        *(u32x4*)(dst + 8 * q) = w;
    }
}
DI void store_f32x32(float* dst, const float* v) {
#pragma unroll
    for (int q = 0; q < 8; ++q) { f32x4 w = {v[4 * q], v[4 * q + 1], v[4 * q + 2], v[4 * q + 3]}; *(f32x4*)(dst + 4 * q) = w; }
}
DI void rope32(float* v, const float* rope, int t) {
    const float* tr = rope + (t >> 6) * 16;
    const float* tc = rope + (t & 63) * 16;
#pragma unroll
    for (int a = 0; a < 2; ++a) {
        const float* tb = a ? tc : tr;
#pragma unroll
        for (int i = 0; i < 8; ++i) {
            const float c = tb[i], s = tb[8 + i];
            const float x0 = v[a * 16 + i], x1 = v[a * 16 + 8 + i];
            v[a * 16 + i] = x0 * c - x1 * s;
            v[a * 16 + 8 + i] = x1 * c + x0 * s;
        }
    }
}

template <int BM, class AF>
DI void gemm_mainloop(LAS unsigned char* lds, const AF& af, int m0, const bf16_t* __restrict__ Bt, int ldb, int n0, int K, f32x16 (&acc)[BM / 64][2]) {
    constexpr int NA = BM * 8 / 256, NB = 4, MI = BM / 64;
    constexpr int STAGE = (BM + 128) * 128;
    const int tid = tidx(), lane = tid & 63, r32 = lane & 31, hh = lane >> 5;
    const int w = __builtin_amdgcn_readfirstlane(tid >> 6), wr = w >> 1, wc = w & 1;
    const bf16_t* ap[NA];
    const bf16_t* bp[NB];
#pragma unroll
    for (int i = 0; i < NA; ++i) { const int p = tid + 256 * i, row = p >> 3, cs = (p & 7) ^ ((row >> 1) & 7); ap[i] = af.row(m0 + row) + cs * 8; }
#pragma unroll
    for (int i = 0; i < NB; ++i) { const int p = tid + 256 * i, row = p >> 3, cs = (p & 7) ^ ((row >> 1) & 7); bp[i] = Bt + (size_t)(n0 + row) * ldb + cs * 8; }
#pragma unroll
    for (int mi = 0; mi < MI; ++mi)
#pragma unroll
        for (int ni = 0; ni < 2; ++ni)
#pragma unroll
            for (int i = 0; i < 16; ++i) acc[mi][ni][i] = 0.f;
    const int nk = K / 64;
    const int xr = (r32 >> 1) & 7;
    const int arow = (wr * (BM / 2) + r32) * 128, brow = (wc * 64 + r32) * 128;
    auto stage = [&](int s, int kt) {
        LAS unsigned char* sa = lds + s * STAGE;
        LAS unsigned char* sb = sa + BM * 128;
#pragma unroll
        for (int i = 0; i < NA; ++i)
            __builtin_amdgcn_global_load_lds((const GAS void*)(ap[i] + kt * 64), (LAS void*)(sa + (w * 64 + 256 * i) * 16), 16, 0, 0);
#pragma unroll
        for (int i = 0; i < NB; ++i)
            __builtin_amdgcn_global_load_lds((const GAS void*)(bp[i] + kt * 64), (LAS void*)(sb + (w * 64 + 256 * i) * 16), 16, 0, 0);
    };
    stage(0, 0);
    for (int kt = 0; kt < nk; ++kt) {
        asm volatile("s_waitcnt vmcnt(0)" ::: "memory");
        __syncthreads();
        if (kt + 1 < nk) stage((kt + 1) & 1, kt + 1);
        LAS const unsigned char* sa = lds + (kt & 1) * STAGE;
        LAS const unsigned char* sb = sa + BM * 128;
#pragma unroll
        for (int kk = 0; kk < 4; ++kk) {
            const int co = (((kk * 2 + hh) ^ xr) << 4);
            bf16x8 a[MI], b[2];
#pragma unroll
            for (int mi = 0; mi < MI; ++mi) a[mi] = *(LAS const bf16x8*)(sa + arow + mi * 32 * 128 + co);
#pragma unroll
            for (int ni = 0; ni < 2; ++ni) b[ni] = *(LAS const bf16x8*)(sb + brow + ni * 32 * 128 + co);
#pragma unroll
            for (int mi = 0; mi < MI; ++mi)
#pragma unroll
                for (int ni = 0; ni < 2; ++ni) acc[mi][ni] = __builtin_amdgcn_mfma_f32_32x32x16_bf16(a[mi], b[ni], acc[mi][ni], 0, 0, 0);
        }
    }
    __syncthreads();
}

template <class EPI>
DI void staged_epilogue(LAS unsigned char* lds, f32x16 (&acc)[2][2], int m0, int n0, const EPI& epi) {
    const int tid = tidx(), lane = tid & 63, r32 = lane & 31, hh = lane >> 5;
    const int w = __builtin_amdgcn_readfirstlane(tid >> 6), wr = w >> 1, wc = w & 1;
    LAS float* st = (LAS float*)lds;
#pragma unroll
    for (int half = 0; half < 2; ++half) {
        if (wr == half) {
#pragma unroll
            for (int mi = 0; mi < 2; ++mi)
#pragma unroll
                for (int ni = 0; ni < 2; ++ni)
#pragma unroll
                    for (int i = 0; i < 16; ++i) st[(mi * 32 + crow(i, hh)) * 132 + wc * 64 + ni * 32 + r32] = acc[mi][ni][i];
        }
        __syncthreads();
        {
            const int row = tid >> 2, ch = tid & 3;
            float v[32];
#pragma unroll
            for (int q = 0; q < 8; ++q) {
                const f32x4 t = *(LAS const f32x4*)(st + row * 132 + ch * 32 + q * 4);
                v[4 * q] = t[0]; v[4 * q + 1] = t[1]; v[4 * q + 2] = t[2]; v[4 * q + 3] = t[3];
            }
            epi(m0 + half * 64 + row, (n0 >> 5) + ch, v);
        }
        __syncthreads();
    }
}

DI void p0_mod_item(const Params& P, LAS unsigned char* lds, int item) {
    const int l = item / 48, n0 = (item % 48) * 64, tid = tidx();
    LAS float* sc = (LAS float*)lds;
    LAS float* red = sc + 5 * 1024;
    const float* c = P.in[8];
    const float* cctx = P.in[9];
    for (int idx = tid; idx < 5 * 1024; idx += 256) {
        const int j = idx >> 10, k = idx & 1023;
        const float x = (j == 0) ? cctx[k] : c[(j - 1) * 1024 + k];
        sc[idx] = x / (1.f + expf(-x));
    }
    __syncthreads();
    const int col = n0 + (tid & 63), kg = tid >> 6;
    const float* wp = P.in[10] + (size_t)l * 1024 * 3072 + (size_t)(kg * 256) * 3072 + col;
    float a0 = 0, a1 = 0, a2 = 0, a3 = 0, a4 = 0;
#pragma unroll 8
    for (int k = 0; k < 256; ++k) {
        const float wv = wp[(size_t)k * 3072];
        const int kk = kg * 256 + k;
        a0 += sc[kk] * wv; a1 += sc[1024 + kk] * wv; a2 += sc[2048 + kk] * wv; a3 += sc[3072 + kk] * wv; a4 += sc[4096 + kk] * wv;
    }
    red[(kg * 5 + 0) * 64 + (tid & 63)] = a0; red[(kg * 5 + 1) * 64 + (tid & 63)] = a1; red[(kg * 5 + 2) * 64 + (tid & 63)] = a2;
    red[(kg * 5 + 3) * 64 + (tid & 63)] = a3; red[(kg * 5 + 4) * 64 + (tid & 63)] = a4;
    __syncthreads();
    float* mod = (float*)(P.ws + WS_MOD);
    for (int idx = tid; idx < 320; idx += 256) {
        const int j = idx >> 6, cc = idx & 63;
        float s = P.in[11][l * 3072 + n0 + cc];
        for (int g = 0; g < 4; ++g) s += red[(g * 5 + j) * 64 + cc];
        mod[(l * 5 + j) * 3072 + n0 + cc] = s;
    }
    __syncthreads();
}

DI void p0_transpose_item(LAS unsigned char* lds, const float* src, int N, int k0, int ns0, int nvalid, bf16_t* dst, int ldd, int nd0, const float* kscale) {
    LAS float* T = (LAS float*)lds;
    const int tid = tidx();
#pragma unroll
    for (int i = 0; i < 4; ++i) {
        const int idx = tid + 256 * i, kk = idx >> 4, n4 = (idx & 15) * 4;
        f32x4 v = {0.f, 0.f, 0.f, 0.f};
        if (n4 < nvalid) v = *(const f32x4*)(src + (size_t)(k0 + kk) * N + ns0 + n4);
        const float s = kscale ? kscale[k0 + kk] : 1.f;
        T[kk * 65 + n4] = v[0] * s; T[kk * 65 + n4 + 1] = v[1] * s; T[kk * 65 + n4 + 2] = v[2] * s; T[kk * 65 + n4 + 3] = v[3] * s;
    }
    __syncthreads();
#pragma unroll
    for (int i = 0; i < 2; ++i) {
        const int idx = tid + 256 * i, nn = idx >> 3, kc = idx & 7;
        float v[8];
#pragma unroll
        for (int j = 0; j < 8; ++j) v[j] = T[(kc * 8 + j) * 65 + nn];
        u32x4 wv = {pk2(v[0], v[1]), pk2(v[2], v[3]), pk2(v[4], v[5]), pk2(v[6], v[7])};
        *(u32x4*)(dst + (size_t)(nd0 + nn) * ldd + k0 + kc * 8) = wv;
    }
    __syncthreads();
}

DI void p0_convert_flat(const float* src, bf16_t* dst, int item) {
    const size_t e = (size_t)item * 2048 + tidx() * 8;
    const f32x4 a = *(const f32x4*)(src + e), b = *(const f32x4*)(src + e + 4);
    u32x4 wv = {pk2(a[0], a[1]), pk2(a[2], a[3]), pk2(b[0], b[1]), pk2(b[2], b[3])};
    *(u32x4*)(dst + e) = wv;
}

constexpr int P0_MOD = 192, P0_WIN = 4 * 16 * 59, P0_WOUT = 4 * 16 * 16, P0_WUQ = 4 * 4 * 6, P0_WUKV = 4 * 2 * 8,
              P0_CA = 1024, P0_CKV = 512, P0_KPE = 128, P0_MISC = 1;
constexpr int P0_TOTAL = P0_MOD + P0_WIN + P0_WOUT + P0_WUQ + P0_WUKV + 4 * P0_CA + P0_CKV + P0_KPE + P0_MISC;

DI void phase0(const Params& P, LAS unsigned char* lds) {
    for (int it = blockIdx.x; it < P0_TOTAL; it += gridDim.x) {
        int item = it;
        if (item < P0_MOD) { p0_mod_item(P, lds, item); continue; }
        item -= P0_MOD;
        if (item < P0_WIN) {
            const int l = item / (16 * 59), r = item % (16 * 59), kt = r / 59, j = r % 59;
            const int ns0 = (j < 38) ? 64 * j : (j < 58 ? 64 * j + 32 : 2432), nvalid = (j == 58) ? 32 : 64;
            p0_transpose_item(lds, P.in[13] + (size_t)l * 1024 * 3744, 3744, kt * 64, ns0, nvalid, (bf16_t*)(P.ws + WS_WIN) + (size_t)l * NPADW * 1024, 1024, j * 64, nullptr);
            continue;
        }
        item -= P0_WIN;
        if (item < P0_WOUT) {
            const int l = item >> 8, r = item & 255, kt = r >> 4, j = r & 15;
            p0_transpose_item(lds, P.in[22] + (size_t)l * 1024 * 1024, 1024, kt * 64, j * 64, 64, (bf16_t*)(P.ws + WS_WOUT) + (size_t)l * 1024 * 1024, 1024, j * 64, nullptr);
            continue;
        }
        item -= P0_WOUT;
        if (item < P0_WUQ) {
            const int l = item / 24, r = item % 24, kt = r / 6, j = r % 6;
            p0_transpose_item(lds, P.in[18] + (size_t)l * 256 * 384, 384, kt * 64, j * 64, 64, (bf16_t*)(P.ws + WS_WUQ) + (size_t)l * 384 * 256, 256, j * 64, P.in[17] + l * 256);
            continue;
        }
        item -= P0_WUQ;
        if (item < P0_WUKV) {
            const int l = item >> 4, r = item & 15, kt = r >> 3, j = r & 7;
            p0_transpose_item(lds, P.in[20] + (size_t)l * 128 * 512, 512, kt * 64, j * 64, 64, (bf16_t*)(P.ws + WS_WUKV) + (size_t)l * 512 * 128, 128, j * 64, nullptr);
            continue;
        }
        item -= P0_WUKV;
        if (item < 4 * P0_CA) {
            const int which = item >> 10, sub = item & 1023;
            const float* srcp = (which == 0) ? P.in[2] : (which == 1) ? P.in[3] : (which == 2) ? P.in[6] : P.in[7];
            const size_t dsto = (which == 0) ? WS_CAK : (which == 1) ? WS_CAV : (which == 2) ? WS_CDK : WS_CDV;
            p0_convert_flat(srcp, (bf16_t*)(P.ws + dsto), sub);
            continue;
        }
        item -= 4 * P0_CA;
        if (item < P0_CKV) { p0_convert_flat(P.in[4], (bf16_t*)(P.ws + WS_CKVC), item); continue; }
        item -= P0_CKV;
        if (item < P0_KPE) {
            const size_t e = (size_t)item * 2048 + tidx() * 8;
            const f32x4 a = *(const f32x4*)(P.in[5] + e), b = *(const f32x4*)(P.in[5] + e + 4);
            u32x4 wv = {pk2(a[0], a[1]), pk2(a[2], a[3]), pk2(b[0], b[1]), pk2(b[2], b[3])};
            const int j0 = (int)(e & 31), rowi = (int)(e >> 5), t = rowi & 511, bl = rowi >> 9, l = bl & 3, b_ = bl >> 2;
            bf16_t* dst = (bf16_t*)(P.ws + WS_KCC) + ((size_t)(l * 4 + b_) * 512 + t) * KCS + 64 + j0;
#pragma unroll
            for (int h = 0; h < 4; ++h) *(u32x4*)(dst + h * 160) = wv;
            continue;
        }
        {
            const int tid = tidx();
            float* rope = (float*)(P.ws + WS_ROPE);
            for (int idx = tid; idx < 512; idx += 256) {
                const int pos = idx >> 3, i = idx & 7;
                const float inv = 1.0f / powf(10000.f, (float)(2 * i) / 16.f);
                const float ang = (float)pos * inv;
                rope[pos * 16 + i] = cosf(ang);
                rope[pos * 16 + 8 + i] = sinf(ang);
            }
            if (tid < 4) {
                const float* lv = P.in[14] + tid * 128;
                float s1 = 0.f, s2 = 0.f;
                for (int d = 0; d < 32; ++d) { s1 += lv[d] * lv[32 + d]; s2 += lv[64 + d] * lv[96 + d]; }
                const float li = 0.8f - 0.6f * expf(-0.3f * (float)tid);
                float* lam = (float*)(P.ws + WS_LAM);
                lam[tid * 2] = expf(s1) - expf(s2) + li;
                lam[tid * 2 + 1] = li;
            }
        }
    }
}

DI const float* xrow_ptr(const Params& P, int layer, int row) {
    if (layer == 0) return (row < NCTX) ? P.in[0] + (size_t)row * DM : P.in[1] + (size_t)(row - NCTX) * DM;
    return P.out + (size_t)row * DM;
}
DI void phaseN(const Params& P, int layer) {
    const int lane = tidx() & 63, w = tidx() >> 6;
    const float* g = P.in[12] + layer * DM;
    bf16_t* H = (bf16_t*)(P.ws + WS_H);
    for (int row = blockIdx.x * 4 + w; row < NTOK; row += gridDim.x * 4) {
        const float* x = xrow_ptr(P, layer, row);
        const int mi = (row < NCTX) ? 0 : 1 + ((row - NCTX) >> 11);
        const float* mod = (const float*)(P.ws + WS_MOD) + (size_t)(layer * 5 + mi) * 3072;
        f32x4 v[4];
        float ss = 0.f;
#pragma unroll
        for (int i = 0; i < 4; ++i) { v[i] = *(const f32x4*)(x + lane * 4 + 256 * i); ss += v[i][0] * v[i][0] + v[i][1] * v[i][1] + v[i][2] * v[i][2] + v[i][3] * v[i][3]; }
        ss = wave_sum(ss);
        const float r = rsqrtf(ss * (1.f / 1024.f) + EPS);
#pragma unroll
        for (int i = 0; i < 4; ++i) {
            const int n = lane * 4 + 256 * i;
            const f32x4 gg = *(const f32x4*)(g + n), sh = *(const f32x4*)(mod + n), sc = *(const f32x4*)(mod + 1024 + n);
            float o[4];
#pragma unroll
            for (int j = 0; j < 4; ++j) o[j] = v[i][j] * r * gg[j] * (1.f + sc[j]) + sh[j];
            u32x2 wv = {pk2(o[0], o[1]), pk2(o[2], o[3])};
            *(u32x2*)(H + (size_t)row * DM + n) = wv;
        }
    }
}
DI void phaseFinal(const Params& P) {
    const int lane = tidx() & 63, w = tidx() >> 6;
    const float* g = P.in[23];
    for (int row = blockIdx.x * 4 + w; row < NTOK; row += gridDim.x * 4) {
        float* x = P.out + (size_t)row * DM;
        f32x4 v[4];
        float ss = 0.f;
#pragma unroll
        for (int i = 0; i < 4; ++i) { v[i] = *(const f32x4*)(x + lane * 4 + 256 * i); ss += v[i][0] * v[i][0] + v[i][1] * v[i][1] + v[i][2] * v[i][2] + v[i][3] * v[i][3]; }
        ss = wave_sum(ss);
        const float r = rsqrtf(ss * (1.f / 1024.f) + EPS);
#pragma unroll
        for (int i = 0; i < 4; ++i) {
            const int n = lane * 4 + 256 * i;
            const f32x4 gg = *(const f32x4*)(g + n);
            f32x4 o = {v[i][0] * r * gg[0], v[i][1] * r * gg[1], v[i][2] * r * gg[2], v[i][3] * r * gg[3]};
            *(f32x4*)(x + n) = o;
        }
    }
}

struct ARowPlain { const bf16_t* base; int ld; DI const bf16_t* row(int m) const { return base + (size_t)m * ld; } };

struct EpiP1 {
    bf16_t* U; bf16_t* KC; float* SSQ; const float* rope; float* out; const float* gkv; int l;
    DI void operator()(int m, int c32, float* v) const {
        const bool lat = (m >= NCTX);
        const int t = (m - NCTX) & 2047;
        const size_t srow = lat ? 0 : ((size_t)((m >> 8) * 4 + l) * 256 + (m & 255));
        bf16_t* urow = U + (size_t)m * USTR + c32 * 32;
        if (c32 < 8) {
            if (lat) rope32(v, rope, t);
#pragma unroll
            for (int j = 0; j < 32; ++j) v[j] *= SC_A;
            store_bf16x32(urow, v);
        } else if (c32 < 16) {
            if (lat) rope32(v, rope, t); else store_f32x32(out + O_SAK + srow * 256 + (c32 - 8) * 32, v);
            store_bf16x32(urow, v);
        } else if (c32 < 24) {
            if (!lat) store_f32x32(out + O_SAV + srow * 256 + (c32 - 16) * 32, v);
            store_bf16x32(urow, v);
        } else if (c32 < 32 || (c32 >= 56 && c32 < 64) || (c32 >= 76 && c32 < 84) || (c32 >= 108 && c32 < 116)) {
#pragma unroll
            for (int j = 0; j < 32; ++j) v[j] = siluf(v[j]);
            store_bf16x32(urow, v);
        } else if (c32 < 56) {
            store_bf16x32(urow, v);
        } else if (c32 < 72) {
            float ss = 0.f;
#pragma unroll
            for (int j = 0; j < 32; ++j) ss += v[j] * v[j];
            SSQ[(size_t)m * 8 + (c32 - 64)] = ss;
            store_bf16x32(urow, v);
        } else if (c32 < 76) {
            float ss = 0.f;
#pragma unroll
            for (int j = 0; j < 32; ++j) ss += v[j] * v[j];
            ss += __shfl_xor(ss, 1);
            ss += __shfl_xor(ss, 2);
            const float r = rsqrtf(ss * (1.f / 128.f) + EPS);
            const float* gp = gkv + (c32 - 72) * 32;
#pragma unroll
            for (int j = 0; j < 32; ++j) v[j] = v[j] * r * gp[j];
            if (!lat) store_f32x32(out + O_SCKV + srow * 128 + (c32 - 72) * 32, v);
            store_bf16x32(urow, v);
        } else if (c32 < 92) {
#pragma unroll
            for (int j = 0; j < 32; ++j) v[j] *= SC_D;
            store_bf16x32(urow, v);
        } else if (c32 < 100) {
            if (!lat) store_f32x32(out + O_SDK + srow * 256 + (c32 - 92) * 32, v);
            store_bf16x32(urow, v);
        } else if (c32 < 108) {
            if (!lat) store_f32x32(out + O_SDV + srow * 256 + (c32 - 100) * 32, v);
            store_bf16x32(urow, v);
        } else if (c32 == 116) {
            if (lat) rope32(v, rope, t); else store_f32x32(out + O_SKPE + srow * 32, v);
            bf16_t* kr = KC + (size_t)m * KCS + 64;
#pragma unroll
            for (int h = 0; h < 4; ++h) store_bf16x32(kr + h * 160, v);
        }
    }
};

DI void phaseP1(const Params& P, LAS unsigned char* lds, int layer) {
    ARowPlain af{(const bf16_t*)(P.ws + WS_H), DM};
    const bf16_t* Bt = (const bf16_t*)(P.ws + WS_WIN) + (size_t)layer * NPADW * 1024;
    EpiP1 epi{(bf16_t*)(P.ws + WS_U), (bf16_t*)(P.ws + WS_KC), (float*)(P.ws + WS_SSQ), (const float*)(P.ws + WS_ROPE), P.out, P.in[19] + layer * 128, layer};
    for (int tile = blockIdx.x; tile < 96 * 30; tile += gridDim.x) {
        const int mt = tile / 30, nt = tile % 30;
        f32x16 acc[2][2];
        gemm_mainloop<128>(lds, af, mt * 128, Bt, 1024, nt * 128, 1024, acc);
        staged_epilogue(lds, acc, mt * 128, nt * 128, epi);
    }
}

struct EpiQ {
    bf16_t* QC; const float* SSQ; const float* rope;
    DI void operator()(int m, int c32, float* v) const {
        const f32x4 s0 = *(const f32x4*)(SSQ + (size_t)m * 8), s1 = *(const f32x4*)(SSQ + (size_t)m * 8 + 4);
        const float ss = s0[0] + s0[1] + s0[2] + s0[3] + s1[0] + s1[1] + s1[2] + s1[3];
        const float r = rsqrtf(ss * (1.f / 256.f) + EPS);
#pragma unroll
        for (int j = 0; j < 32; ++j) v[j] *= r;
        if ((c32 % 3) == 2 && m >= NCTX) rope32(v, rope, (m - NCTX) & 2047);
#pragma unroll
        for (int j = 0; j < 32; ++j) v[j] *= SC_C;
        store_bf16x32(QC + (size_t)m * 384 + c32 * 32, v);
    }
};
struct ARowKV {
    const bf16_t* U; const bf16_t* ckvc; int l;
    DI const bf16_t* row(int m) const {
        if (m < NTOK) return U + (size_t)m * USTR + U_CKV;
        const int mm = m - NTOK, b = mm >> 9, t = mm & 511;
        return ckvc + ((size_t)(b * 4 + l) * 512 + t) * 128;
    }
};
struct EpiKV {
    bf16_t* KC; bf16_t* KCC; int l;
    DI void operator()(int m, int c32, float* v) const {
        const int head = c32 >> 2, part = c32 & 3;
        bf16_t* dst;
        if (m < NTOK) dst = KC + (size_t)m * KCS;
        else { const int mm = m - NTOK, b = mm >> 9, t = mm & 511; dst = KCC + ((size_t)(l * 4 + b) * 512 + t) * KCS; }
        dst += head * 160 + (part < 2 ? part * 32 : 96 + (part - 2) * 32);
        store_bf16x32(dst, v);
    }
};
DI void phaseP1b(const Params& P, LAS unsigned char* lds, int layer) {
    const int NQ = 96 * 3, NKV = 112 * 4;
    for (int it = blockIdx.x; it < NQ + NKV; it += gridDim.x) {
        f32x16 acc[2][2];
        if (it < NQ) {
            const int mt = it / 3, nt = it % 3;
            ARowPlain af{(const bf16_t*)(P.ws + WS_U) + U_CQ, USTR};
            EpiQ epi{(bf16_t*)(P.ws + WS_QC), (const float*)(P.ws + WS_SSQ), (const float*)(P.ws + WS_ROPE)};
            gemm_mainloop<128>(lds, af, mt * 128, (const bf16_t*)(P.ws + WS_WUQ) + (size_t)layer * 384 * 256, 256, nt * 128, 256, acc);
            staged_epilogue(lds, acc, mt * 128, nt * 128, epi);
        } else {
            const int j = it - NQ, mt = j >> 2, nt = j & 3;
            ARowKV af{(const bf16_t*)(P.ws + WS_U), (const bf16_t*)(P.ws + WS_CKVC), layer};
            EpiKV epi{(bf16_t*)(P.ws + WS_KC), (bf16_t*)(P.ws + WS_KCC), layer};
            gemm_mainloop<128>(lds, af, mt * 128, (const bf16_t*)(P.ws + WS_WUKV) + (size_t)layer * 512 * 128, 128, nt * 128, 128, acc);
            staged_epilogue(lds, acc, mt * 128, nt * 128, epi);
        }
    }
}

struct AttnDesc {
    const bf16_t* q; int qs;
    const bf16_t* k0; const bf16_t* v0; int ks0, vs0, nt0;
    const bf16_t* k1; const bf16_t* v1; int ks1, vs1;
    int nt;
    bf16_t* out; const bf16_t* sz;
    float lam, oml; const float* subg;
    const float* rpb; int qrow0, rs;
};

template <int MODE>
DI void attn_unit(const AttnDesc& d, LAS unsigned char* lds) {
    constexpr int DQK = (MODE == 1) ? 96 : 64;
    constexpr int NMAP = (MODE == 0) ? 2 : 1;
    constexpr int NKK = DQK / 16;
    constexpr int KSTR = DQK * 2 + 16;
    constexpr int NKC = DQK / 8;
    constexpr int NKL = 64 * NKC / 256;
    constexpr int KBUF = 64 * KSTR;
    constexpr int VOFF = 2 * 64 * 208;
    constexpr int BOFF = VOFF + 16384;
    constexpr float THR = 6.f;
    const int tid = tidx(), lane = tid & 63, r32 = lane & 31, hh = lane >> 5;
    const int w = __builtin_amdgcn_readfirstlane(tid >> 6);

    bf16x8 qf[NKK];
    {
        const bf16_t* qrow = d.q + (size_t)(w * 32 + r32) * d.qs + hh * 8;
#pragma unroll
        for (int kk = 0; kk < NKK; ++kk) qf[kk] = *(const bf16x8*)(qrow + kk * 16);
    }
    const bool has_bias = (MODE == 2) && (d.rpb != nullptr);
    if (MODE == 2 && has_bias) {
        LAS float* bt = (LAS float*)(lds + BOFF);
        for (int idx = tid; idx < 15 * 31; idx += 256) bt[(idx / 31) * 32 + (idx % 31)] = d.rpb[idx] * LOG2E;
    }
    float m[NMAP], l[NMAP];
    f32x16 o[NMAP][2];
#pragma unroll
    for (int mp = 0; mp < NMAP; ++mp) {
        m[mp] = NEGBIG; l[mp] = 0.f;
#pragma unroll
        for (int i = 0; i < 16; ++i) { o[mp][0][i] = 0.f; o[mp][1][i] = 0.f; }
    }
    u32x4 kreg[NKL], vreg[2];
    auto load_tile = [&](int t) {
        const bf16_t* kb; const bf16_t* vb; int ks, vs;
        if (t < d.nt0) { kb = d.k0 + (size_t)t * 64 * d.ks0; vb = d.v0 + (size_t)t * 64 * d.vs0; ks = d.ks0; vs = d.vs0; }
        else { kb = d.k1 + (size_t)(t - d.nt0) * 64 * d.ks1; vb = d.v1 + (size_t)(t - d.nt0) * 64 * d.vs1; ks = d.ks1; vs = d.vs1; }
#pragma unroll
        for (int i = 0; i < NKL; ++i) { const int c = tid + 256 * i, row = c / NKC, ch = c % NKC; kreg[i] = *(const u32x4*)(kb + (size_t)row * ks + ch * 8); }
#pragma unroll
        for (int i = 0; i < 2; ++i) { const int c = tid + 256 * i, row = c >> 3, ch = c & 7; vreg[i] = *(const u32x4*)(vb + (size_t)row * vs + ch * 8); }
    };
    auto store_tile = [&](int buf) {
        LAS unsigned char* kd = lds + buf * KBUF;
        LAS unsigned char* vd = lds + VOFF + buf * 8192;
#pragma unroll
        for (int i = 0; i < NKL; ++i) { const int c = tid + 256 * i, row = c / NKC, ch = c % NKC; *(LAS u32x4*)(kd + row * KSTR + ch * 16) = kreg[i]; }
#pragma unroll
        for (int i = 0; i < 2; ++i) { const int c = tid + 256 * i, row = c >> 3, ch = c & 7; *(LAS u32x4*)(vd + row * 128 + ((ch * 16) ^ (((row >> 1) & 1) << 6))) = vreg[i]; }
    };
    const int q4 = (lane & 15) >> 2, p4 = lane & 3, g16 = (lane >> 4) & 1, xs = (q4 >> 1) & 1;
    const int vlane = (4 * hh + q4) * 128 + g16 * 32 + p4 * 8;
    const int rq = d.qrow0 + (w >> 1), qc = (w & 1) * 32 + r32;
    const int rst = min(max(rq - 4, 0), 24), wst = min(max(qc - 8, 0), 48);

    load_tile(0);
    store_tile(0);
    __syncthreads();
    for (int t = 0; t < d.nt; ++t) {
        const int cur = t & 1;
        if (t + 1 < d.nt) load_tile(t + 1);
        bool valid = true;
        int dy = 0;
        if (MODE == 2 && has_bias && t >= d.nt0) { const int krow = d.rs + (t - d.nt0); valid = (krow >= rst) && (krow < rst + 8); dy = krow - rq + 7; }
        if (valid) {
            LAS const unsigned char* kb = lds + cur * KBUF;
            LAS const unsigned char* vb = lds + VOFF + cur * 8192;
            bf16x8 pf[NMAP][2][2];
#pragma unroll
            for (int mp = 0; mp < NMAP; ++mp) {
                f32x16 s[2];
#pragma unroll
                for (int sub = 0; sub < 2; ++sub) {
#pragma unroll
                    for (int i = 0; i < 16; ++i) s[sub][i] = 0.f;
#pragma unroll
                    for (int k2 = 0; k2 < NKK / NMAP; ++k2) {
                        const int kk = mp * (NKK / NMAP) + k2;
                        const bf16x8 a = *(LAS const bf16x8*)(kb + (sub * 32 + r32) * KSTR + kk * 32 + hh * 16);
                        s[sub] = __builtin_amdgcn_mfma_f32_32x32x16_bf16(a, qf[kk], s[sub], 0, 0, 0);
                    }
                }
                if (MODE == 2 && has_bias && t >= d.nt0) {
                    int kofs = 4 * hh - wst, bidx = dy * 32 + 4 * hh - qc + 15;
                    asm volatile("" : "+v"(kofs), "+v"(bidx));
                    LAS const float* bt = (LAS const float*)(lds + BOFF) + bidx;
#pragma unroll
                    for (int sub = 0; sub < 2; ++sub)
#pragma unroll
                        for (int i = 0; i < 16; ++i) {
                            const int kci = sub * 32 + (i & 3) + 8 * (i >> 2);
                            const bool inw = (unsigned)(kci + kofs) < 16u;
                            s[sub][i] = inw ? s[sub][i] + bt[kci] : NEGBIG;
                        }
                }
                float mx = s[0][0];
#pragma unroll
                for (int i = 1; i < 16; ++i) mx = fmaxf(mx, s[0][i]);
#pragma unroll
                for (int i = 0; i < 16; ++i) mx = fmaxf(mx, s[1][i]);
                mx = half_swap_max(mx);
                const float mnew = fmaxf(m[mp], mx);
                if (__any((mnew - m[mp]) > THR)) {
                    const float alpha = __builtin_amdgcn_exp2f(m[mp] - mnew);
#pragma unroll
                    for (int i = 0; i < 16; ++i) { o[mp][0][i] *= alpha; o[mp][1][i] *= alpha; }
                    l[mp] *= alpha;
                    m[mp] = mnew;
                }
                float ps = 0.f;
#pragma unroll
                for (int sub = 0; sub < 2; ++sub)
#pragma unroll
                    for (int i = 0; i < 16; ++i) { const float p = __builtin_amdgcn_exp2f(s[sub][i] - m[mp]); s[sub][i] = p; ps += p; }
                l[mp] += ps;
#pragma unroll
                for (int sub = 0; sub < 2; ++sub)
#pragma unroll
                    for (int st = 0; st < 2; ++st) {
                        u32x4 pw = {pk2(s[sub][8 * st], s[sub][8 * st + 1]), pk2(s[sub][8 * st + 2], s[sub][8 * st + 3]),
                                    pk2(s[sub][8 * st + 4], s[sub][8 * st + 5]), pk2(s[sub][8 * st + 6], s[sub][8 * st + 7])};
                        pf[mp][sub][st] = __builtin_bit_cast(bf16x8, pw);
                    }
            }
#pragma unroll
            for (int sub = 0; sub < 2; ++sub)
#pragma unroll
                for (int st = 0; st < 2; ++st)
#pragma unroll
                    for (int dvb = 0; dvb < 2; ++dvb) {
                        LAS const unsigned char* va = vb + vlane + (sub * 32 + st * 16) * 128 + ((dvb ^ xs) * 64);
                        const s16x4 lo = __builtin_bit_cast(s16x4, __builtin_amdgcn_ds_read_tr16_b64_v4i16((LAS s16x4*)(va)));
                        const s16x4 hi = __builtin_bit_cast(s16x4, __builtin_amdgcn_ds_read_tr16_b64_v4i16((LAS s16x4*)(va + 8 * 128)));
                        const bf16x8 vf = {lo[0], lo[1], lo[2], lo[3], hi[0], hi[1], hi[2], hi[3]};
#pragma unroll
                        for (int mp = 0; mp < NMAP; ++mp) o[mp][dvb] = __builtin_amdgcn_mfma_f32_32x32x16_bf16(vf, pf[mp][sub][st], o[mp][dvb], 0, 0, 0);
                    }
        }
        if (t + 1 < d.nt) store_tile(cur ^ 1);
        __syncthreads();
    }
    float y[2][16];
    {
        float inv[NMAP];
#pragma unroll
        for (int mp = 0; mp < NMAP; ++mp) inv[mp] = 1.f / half_swap_sum(l[mp]);
        if (MODE == 0) {
            float ss = 0.f;
#pragma unroll
            for (int dvb = 0; dvb < 2; ++dvb)
#pragma unroll
                for (int i = 0; i < 16; ++i) { const float v = o[0][dvb][i] * inv[0] - d.lam * (o[NMAP - 1][dvb][i] * inv[NMAP - 1]); y[dvb][i] = v; ss += v * v; }
            ss = half_swap_sum(ss);
            const float r = rsqrtf(ss * (1.f / 64.f) + EPS) * d.oml;
#pragma unroll
            for (int dvb = 0; dvb < 2; ++dvb)
#pragma unroll
                for (int i = 0; i < 16; ++i) y[dvb][i] *= r * d.subg[dvb * 32 + crow(i, hh)];
        } else {
#pragma unroll
            for (int dvb = 0; dvb < 2; ++dvb)
#pragma unroll
                for (int i = 0; i < 16; ++i) y[dvb][i] = o[0][dvb][i] * inv[0];
        }
    }
    LAS bf16_t* stg = (LAS bf16_t*)(lds + w * 32 * 144);
#pragma unroll
    for (int dvb = 0; dvb < 2; ++dvb)
#pragma unroll
        for (int i = 0; i < 16; ++i) stg[r32 * 72 + dvb * 32 + crow(i, hh)] = (bf16_t)(pk2(y[dvb][i], 0.f) & 0xffffu);
    __builtin_amdgcn_s_waitcnt(0xc07f);
#pragma unroll
    for (int i = 0; i < 4; ++i) {
        const int idx = lane + 64 * i, row = idx >> 3, ch = idx & 7;
        const u32x4 ov = *(LAS const u32x4*)((LAS const unsigned char*)stg + row * 144 + ch * 16);
        const u32x4 zv = *(const u32x4*)(d.sz + (size_t)(w * 32 + row) * USTR + ch * 8);
        u32x4 rv;
#pragma unroll
        for (int j = 0; j < 4; ++j) {
            const float a0 = bf2f(ov[j] & 0xffffu) * bf2f(zv[j] & 0xffffu), a1 = bf2f(ov[j] >> 16) * bf2f(zv[j] >> 16);
            rv[j] = pk2(a0, a1);
        }
        *(u32x4*)(d.out + (size_t)(w * 32 + row) * DM + ch * 8) = rv;
    }
    __syncthreads();
}

DI void conv_item(const Params& P, int layer, int tile) {
    const bf16_t* U = (const bf16_t*)(P.ws + WS_U);
    bf16_t* YG = (bf16_t*)(P.ws + WS_YG);
    const float* cw = P.in[16] + layer * 3 * 256;
    const int g0 = tile * 128;
#pragma unroll 2
    for (int i = 0; i < 16; ++i) {
        const int idx = tidx() + 256 * i, tk = idx >> 5, ch = idx & 31, g = g0 + tk;
        const int tpos = (g < NCTX) ? (g & 255) : ((g - NCTX) & 2047), L = (g < NCTX) ? 256 : 2048;
        const bf16_t* ur = U + (size_t)g * USTR + ch * 8;
        const u32x4 bb = *(const u32x4*)(ur + U_BB), zz = *(const u32x4*)(ur + U_BZ);
        float acc[8];
#pragma unroll
        for (int j = 0; j < 8; ++j) acc[j] = 0.f;
#pragma unroll
        for (int dd = 0; dd < 3; ++dd) {
            const int tp = tpos + dd - 1;
            if (tp >= 0 && tp < L) {
                const bf16_t* nr = ur + (ptrdiff_t)(dd - 1) * USTR;
                const u32x4 bc = *(const u32x4*)(nr + U_BC), bh = *(const u32x4*)(nr + U_BH);
                const f32x4 w0 = *(const f32x4*)(cw + dd * 256 + ch * 8), w1 = *(const f32x4*)(cw + dd * 256 + ch * 8 + 4);
#pragma unroll
                for (int j = 0; j < 4; ++j) {
                    acc[2 * j] += bf2f(bc[j] & 0xffffu) * bf2f(bh[j] & 0xffffu) * (j < 2 ? w0[2 * j] : w1[2 * j - 4]);
                    acc[2 * j + 1] += bf2f(bc[j] >> 16) * bf2f(bh[j] >> 16) * (j < 2 ? w0[2 * j + 1] : w1[2 * j - 3]);
                }
            }
        }
        u32x4 rv;
#pragma unroll
        for (int j = 0; j < 4; ++j) {
            const float a0 = acc[2 * j] * bf2f(bb[j] & 0xffffu) * bf2f(zz[j] & 0xffffu), a1 = acc[2 * j + 1] * bf2f(bb[j] >> 16) * bf2f(zz[j] >> 16);
            rv[j] = pk2(a0, a1);
        }
        *(u32x4*)(YG + (size_t)g * DM + 256 + ch * 8) = rv;
    }
}

constexpr int P2_ITEMS = 768 + 384 + 96;
DI int rstart(int r) { return min(max(r - 4, 0), 24); }

DI void phaseP2(const Params& P, LAS unsigned char* lds, int layer, int phase_id) {
    const bf16_t* U = (const bf16_t*)(P.ws + WS_U);
    const bf16_t* KC = (const bf16_t*)(P.ws + WS_KC);
    const bf16_t* KCC = (const bf16_t*)(P.ws + WS_KCC);
    const bf16_t* QC = (const bf16_t*)(P.ws + WS_QC);
    bf16_t* YG = (bf16_t*)(P.ws + WS_YG);
    unsigned* ctr = (unsigned*)(P.ws + WS_CTL) + CW_QUEUE + 64 * phase_id;
    LAS volatile int* sitem = (LAS volatile int*)(lds + LDS_CTLOFF + 16);
    const float* lamp = (const float*)(P.ws + WS_LAM) + layer * 2;
    for (;;) {
        if (tidx() == 0) *sitem = (int)atomicAdd(ctr, 1u);
        __syncthreads();
        const int item = *sitem;
        __syncthreads();
        if (item >= P2_ITEMS) break;
        AttnDesc d;
        d.k1 = nullptr; d.v1 = nullptr; d.ks1 = 0; d.vs1 = 0; d.rpb = nullptr; d.qrow0 = 0; d.rs = 0; d.lam = 0.f; d.oml = 0.f; d.subg = nullptr;
        if (item >= 1152) { conv_item(P, layer, item - 1152); continue; }
        int kind;
        if (item < 768) {
            const int j = item & 255, b = j >> 6, h = (j >> 4) & 3, qb = j & 15;
            kind = item >> 8;
            const size_t tokb = NCTX + (size_t)b * 2048, tok0 = tokb + qb * 128;
            const size_t crow0 = (size_t)(b * 4 + layer) * 512;
            d.nt0 = 8; d.nt = 40;
            if (kind == 0) {
                d.q = U + tok0 * USTR + U_AQ + h * 64; d.qs = USTR;
                d.k0 = (const bf16_t*)(P.ws + WS_CAK) + crow0 * 256 + h * 64; d.v0 = (const bf16_t*)(P.ws + WS_CAV) + crow0 * 256 + h * 64; d.ks0 = 256; d.vs0 = 256;
                d.k1 = U + tokb * USTR + U_AK + h * 64; d.v1 = U + tokb * USTR + U_AV + h * 64; d.ks1 = USTR; d.vs1 = USTR;
                d.out = YG + tok0 * DM + h * 64; d.sz = U + tok0 * USTR + U_AZ + h * 64;
            } else if (kind == 1) {
                d.q = QC + tok0 * 384 + h * 96; d.qs = 384;
                d.k0 = KCC + ((size_t)(layer * 4 + b) * 512) * KCS + h * 160; d.v0 = d.k0 + 96; d.ks0 = KCS; d.vs0 = KCS;
                d.k1 = KC + tokb * KCS + h * 160; d.v1 = d.k1 + 96; d.ks1 = KCS; d.vs1 = KCS;
                d.out = YG + tok0 * DM + 512 + h * 64; d.sz = U + tok0 * USTR + U_CZ + h * 64;
            } else {
                const int r = 2 * qb, rs = rstart(r), nloc = 8 + rstart(r + 1) - rs;
                d.q = U + tok0 * USTR + U_DQ + h * 64; d.qs = USTR;
                d.k0 = (const bf16_t*)(P.ws + WS_CDK) + crow0 * 256 + h * 64; d.v0 = (const bf16_t*)(P.ws + WS_CDV) + crow0 * 256 + h * 64; d.ks0 = 256; d.vs0 = 256;
                d.k1 = U + (tokb + rs * 64) * USTR + U_DK + h * 64; d.v1 = U + (tokb + rs * 64) * USTR + U_DV + h * 64; d.ks1 = USTR; d.vs1 = USTR; d.nt = 8 + nloc;
                d.out = YG + tok0 * DM + 768 + h * 64; d.sz = U + tok0 * USTR + U_DZ + h * 64;
                d.rpb = P.in[21] + (size_t)(layer * 4 + h) * 15 * 31; d.qrow0 = r; d.rs = rs;
            }
        } else {
            const int jj = item - 768, j = jj & 127, b = j >> 3, h = (j >> 1) & 3, qb = j & 1;
            kind = jj >> 7;
            const size_t tokb = (size_t)b * 256, tok0 = tokb + qb * 128;
            d.nt0 = 4; d.nt = 4;
            if (kind == 0) {
                d.q = U + tok0 * USTR + U_AQ + h * 64; d.qs = USTR;
                d.k0 = U + tokb * USTR + U_AK + h * 64; d.v0 = U + tokb * USTR + U_AV + h * 64; d.ks0 = USTR; d.vs0 = USTR;
                d.out = YG + tok0 * DM + h * 64; d.sz = U + tok0 * USTR + U_AZ + h * 64;
            } else if (kind == 1) {
                d.q = QC + tok0 * 384 + h * 96; d.qs = 384;
                d.k0 = KC + tokb * KCS + h * 160; d.v0 = d.k0 + 96; d.ks0 = KCS; d.vs0 = KCS;
                d.out = YG + tok0 * DM + 512 + h * 64; d.sz = U + tok0 * USTR + U_CZ + h * 64;
            } else {
                d.q = U + tok0 * USTR + U_DQ + h * 64; d.qs = USTR;
                d.k0 = U + tokb * USTR + U_DK + h * 64; d.v0 = U + tokb * USTR + U_DV + h * 64; d.ks0 = USTR; d.vs0 = USTR;
                d.out = YG + tok0 * DM + 768 + h * 64; d.sz = U + tok0 * USTR + U_DZ + h * 64;
            }
        }
        if (kind == 0) {
            d.lam = lamp[0]; d.oml = 1.f - lamp[1]; d.subg = P.in[15] + layer * 64;
            attn_unit<0>(d, lds);
        } else if (kind == 1) attn_unit<1>(d, lds);
        else attn_unit<2>(d, lds);
    }
}

DI void phaseP3(const Params& P, LAS unsigned char* lds, int layer) {
    ARowPlain af{(const bf16_t*)(P.ws + WS_YG), DM};
    const bf16_t* Bt = (const bf16_t*)(P.ws + WS_WOUT) + (size_t)layer * 1024 * 1024;
    const int lane = tidx() & 63, r32 = lane & 31, hh = lane >> 5;
    const int w = __builtin_amdgcn_readfirstlane(tidx() >> 6), wr = w >> 1, wc = w & 1;
    for (int tile = blockIdx.x; tile < 192 * 8; tile += gridDim.x) {
        const int mt = tile >> 3, nt = tile & 7, m0 = mt * 64, n0 = nt * 128;
        f32x16 acc[1][2];
        gemm_mainloop<64>(lds, af, m0, Bt, 1024, n0, 1024, acc);
        const int mi = (m0 < NCTX) ? 0 : 1 + ((m0 - NCTX) >> 11);
        const float* gate = (const float*)(P.ws + WS_MOD) + (size_t)(layer * 5 + mi) * 3072 + 2048;
#pragma unroll
        for (int ni = 0; ni < 2; ++ni) {
            const int n = n0 + wc * 64 + ni * 32 + r32;
            const float gt = gate[n];
#pragma unroll
            for (int i = 0; i < 16; ++i) {
                const int mrow = m0 + wr * 32 + crow(i, hh);
                const float xv = xrow_ptr(P, layer, mrow)[n];
                P.out[(size_t)mrow * DM + n] = xv + gt * acc[0][ni][i];
            }
        }
    }
}

__global__ void __launch_bounds__(256, 2) hybrid_fwd(Params P) {
    extern __shared__ __attribute__((aligned(16))) unsigned char smem[];
    LAS unsigned char* lds = (LAS unsigned char*)smem;
#if MEGA
    cg::grid_group grid = cg::this_grid();
#endif
    for (int ph = P.ph_lo; ph < P.ph_hi; ++ph) {
        if (ph == 0) phase0(P, lds);
        else if (ph == NPHASE - 1) phaseFinal(P);
        else {
            const int layer = (ph - 1) / 5, sub = (ph - 1) % 5;
            if (sub == 0) phaseN(P, layer);
            else if (sub == 1) phaseP1(P, lds, layer);
            else if (sub == 2) phaseP1b(P, lds, layer);
            else if (sub == 3) phaseP2(P, lds, layer, ph);
            else phaseP3(P, lds, layer);
        }
#if MEGA
        if (ph + 1 < P.ph_hi) grid.sync();
#endif
    }
}

extern "C" void kernel_launch(void* const* d_in, const int* in_sizes, int n_in, void* d_out, int out_size, void* d_ws, size_t ws_size, hipStream_t stream) {
    static int grid_blocks = 0;
    if (grid_blocks == 0) {
        if (n_in != 24 || ws_size < WS_END) { fprintf(stderr, "kernel_launch: unexpected inputs (n_in %d, ws %zu)\n", n_in, ws_size); grid_blocks = -1; return; }
        int dev = 0, cus = 0, per_cu = 0;
        hipGetDevice(&dev);
        hipDeviceGetAttribute(&cus, hipDeviceAttributeMultiprocessorCount, dev);
        hipFuncSetAttribute((const void*)hybrid_fwd, hipFuncAttributeMaxDynamicSharedMemorySize, LDS_BYTES);
        hipOccupancyMaxActiveBlocksPerMultiprocessor(&per_cu, (const void*)hybrid_fwd, 256, LDS_BYTES);
        if (per_cu < 1) { fprintf(stderr, "kernel_launch: occupancy query says %d blocks per CU\n", per_cu); per_cu = 1; }
        if (per_cu > 2) per_cu = 2;
        grid_blocks = cus * per_cu;
        (void)hipGetLastError();
    }
    if (grid_blocks < 0) return;
    hipMemsetAsync((char*)d_ws + WS_CTL, 0, 65536, stream);
    Params p{};
    for (int i = 0; i < 24; ++i) p.in[i] = (const float*)d_in[i];
    p.out = (float*)d_out;
    p.ws = (unsigned char*)d_ws;
#if MEGA
    p.ph_lo = 0; p.ph_hi = NPHASE;
    void* args[] = {&p};
    hipError_t e = hipLaunchCooperativeKernel((const void*)hybrid_fwd, dim3(grid_blocks), dim3(256), args, LDS_BYTES, stream);
    if (e != hipSuccess) fprintf(stderr, "cooperative launch failed: %s (grid %d)\n", hipGetErrorString(e), grid_blocks);
#else
    for (int ph = 0; ph < NPHASE; ++ph) {
        p.ph_lo = ph; p.ph_hi = ph + 1;
        hipLaunchKernelGGL(hybrid_fwd, dim3(grid_blocks), dim3(256), LDS_BYTES, stream, p);
    }
#endif
}
```

```cpp
#include <hip/hip_runtime.h>
#include <hip/hip_cooperative_groups.h>
#include <stdint.h>
#include <stdio.h>
namespace cg = cooperative_groups;

#ifndef MEGA
#define MEGA 1
#endif
#ifndef FUSE_N
#define FUSE_N 0
#endif
#ifndef REPEAT_MASK
#define REPEAT_MASK 0
#endif

#define DI __device__ __forceinline__
#define LAS __attribute__((address_space(3)))
#define GAS __attribute__((address_space(1)))
typedef unsigned short bf16_t;
typedef short bf16x8 __attribute__((ext_vector_type(8)));
typedef short s16x4 __attribute__((ext_vector_type(4)));
typedef float f32x16 __attribute__((ext_vector_type(16)));
typedef float f32x4 __attribute__((ext_vector_type(4)));
typedef float f32x2 __attribute__((ext_vector_type(2)));
typedef unsigned u32x4 __attribute__((ext_vector_type(4)));
typedef unsigned u32x2 __attribute__((ext_vector_type(2)));
typedef __bf16 bf16v2 __attribute__((ext_vector_type(2)));

constexpr int DM = 1024, NCTX = 4096, NLAT = 8192, NTOK = 12288, DEPTH = 4;
constexpr int USTR = 3744;
constexpr int NPADW = 3840;
constexpr int U_AQ = 0, U_AK = 256, U_AV = 512, U_AZ = 768, U_BB = 1024, U_BC = 1280, U_BH = 1536, U_BZ = 1792,
              U_CQ = 2048, U_CKV = 2304, U_CZ = 2432, U_DQ = 2688, U_DK = 2944, U_DV = 3200, U_DZ = 3456, U_KPE = 3712;
constexpr int KCS = 640;
constexpr float LOG2E = 1.4426950408889634f, EPS = 1e-6f;
constexpr float SC_A = 0.17677669529663687f * LOG2E;
constexpr float SC_C = 0.10206207261596575f * LOG2E;
constexpr float SC_D = 0.125f * LOG2E;
constexpr float NEGBIG = -1e30f;

constexpr size_t O_YP = 0, O_YS = 4194304, O_SAK = 12582912, O_SAV = 16777216, O_SCKV = 20971520, O_SKPE = 23068672,
                 O_SDK = 23592960, O_SDV = 27787264;

constexpr size_t WS_CTL = 0;
constexpr size_t WS_MOD = 65536;
constexpr size_t WS_ROPE = WS_MOD + 4 * 5 * 3072 * 4;
constexpr size_t WS_LAM = WS_ROPE + 64 * 16 * 4;
constexpr size_t WS_SSQ = WS_LAM + 256;
constexpr size_t WS_WIN = WS_SSQ + (size_t)NTOK * 8 * 4;
constexpr size_t WS_WOUT = WS_WIN + (size_t)4 * NPADW * 1024 * 2;
constexpr size_t WS_WUQ = WS_WOUT + (size_t)4 * 1024 * 1024 * 2;
constexpr size_t WS_WUKV = WS_WUQ + (size_t)4 * 384 * 256 * 2;
constexpr size_t WS_CAK = WS_WUKV + (size_t)4 * 512 * 128 * 2;
constexpr size_t WS_CAV = WS_CAK + 4194304;
constexpr size_t WS_CDK = WS_CAV + 4194304;
constexpr size_t WS_CDV = WS_CDK + 4194304;
constexpr size_t WS_CKVC = WS_CDV + 4194304;
constexpr size_t WS_KCC = WS_CKVC + 2097152;
constexpr size_t WS_H = WS_KCC + (size_t)4 * 4 * 512 * KCS * 2;
constexpr size_t WS_U = WS_H + (size_t)NTOK * 1024 * 2;
constexpr size_t WS_KC = WS_U + (size_t)NTOK * USTR * 2;
constexpr size_t WS_QC = WS_KC + (size_t)NTOK * KCS * 2;
constexpr size_t WS_YG = WS_QC + (size_t)NTOK * 384 * 2;
constexpr size_t WS_XB = WS_YG + (size_t)NTOK * 1024 * 2;
constexpr size_t WS_END = WS_XB + (size_t)NTOK * 1024 * 2;
static_assert(WS_END <= (size_t)256 * 1024 * 1024, "workspace map exceeds 256 MiB");
static_assert(WS_WIN % 256 == 0 && WS_U % 256 == 0 && WS_KC % 256 == 0 && WS_QC % 256 == 0 && WS_YG % 256 == 0 && WS_H % 256 == 0, "align");

constexpr int NT = 512;
constexpr int CW_DEP = 4096;
constexpr int LDS_CTLOFF = 147456;
constexpr int LDS_BYTES = LDS_CTLOFF + 64;
constexpr int NPHASE = 14;
constexpr int CW_QUEUE = 64;

struct Params {
    const float* in[24];
    float* out;
    unsigned char* ws;
    int ph_lo, ph_hi;
};

DI int tidx() { int t = threadIdx.x; asm volatile("" : "+v"(t)); return t; }
DI int bidx() { int b = blockIdx.x; asm volatile("" : "+s"(b)); return b; }
DI float bf2f(unsigned b) { return __uint_as_float(b << 16); }
DI unsigned pk2(float lo, float hi) { f32x2 v = {lo, hi}; bf16v2 b = __builtin_convertvector(v, bf16v2); return __builtin_bit_cast(unsigned, b); }
DI float shx(float v, int mask) {
    const int lane = tidx() & 63;
    return __uint_as_float((unsigned)__builtin_amdgcn_ds_bpermute(((lane ^ mask) << 2), (int)__float_as_uint(v)));
}
DI float wave_sum(float v) {
#pragma unroll
    for (int o = 32; o >= 1; o >>= 1) v += shx(v, o);
    return v;
}
DI float half_swap_max(float v) {
    auto rr = __builtin_amdgcn_permlane32_swap(__float_as_uint(v), __float_as_uint(v), false, false);
    return fmaxf(__uint_as_float(rr[0]), __uint_as_float(rr[1]));
}
DI float half_swap_sum(float v) {
    auto rr = __builtin_amdgcn_permlane32_swap(__float_as_uint(v), __float_as_uint(v), false, false);
    return __uint_as_float(rr[0]) + __uint_as_float(rr[1]);
}
DI float eps_() { float e = EPS; asm volatile("" : "+v"(e)); return e; }
DI int crow(int i, int hh) { return (i & 3) + 8 * (i >> 2) + 4 * hh; }
DI float siluf(float x) { return x * __builtin_amdgcn_rcpf(1.f + __builtin_amdgcn_exp2f(x * -1.44269504f)); }
DI void store_bf16x32(bf16_t* dst, const float* v) {
#pragma unroll
    for (int q = 0; q < 4; ++q) {
        u32x4 w = {pk2(v[8 * q], v[8 * q + 1]), pk2(v[8 * q + 2], v[8 * q + 3]), pk2(v[8 * q + 4], v[8 * q + 5]), pk2(v[8 * q + 6], v[8 * q + 7])};
        *(u32x4*)(dst + 8 * q) = w;
    }
}
DI void store_f32x32(float* dst, const float* v) {
#pragma unroll
    for (int q = 0; q < 8; ++q) { f32x4 w = {v[4 * q], v[4 * q + 1], v[4 * q + 2], v[4 * q + 3]}; *(f32x4*)(dst + 4 * q) = w; }
}
DI void rope32(float* v, const float* rope, int t) {
    const float* tr = rope + (t >> 6) * 16;
    const float* tc = rope + (t & 63) * 16;
#pragma unroll
    for (int a = 0; a < 2; ++a) {
        const float* tb = a ? tc : tr;
#pragma unroll
        for (int i = 0; i < 8; ++i) {
            const float c = tb[i], s = tb[8 + i];
            const float x0 = v[a * 16 + i], x1 = v[a * 16 + 8 + i];
            v[a * 16 + i] = x0 * c - x1 * s;
            v[a * 16 + 8 + i] = x1 * c + x0 * s;
        }
    }
}

template <int BM, class AF>
DI void gemm_mainloop(LAS unsigned char* lds, const AF& af, int m0, const bf16_t* __restrict__ Bt, int ldb, int n0, int K, f32x16 (&acc)[BM / 128][2]) {
    constexpr int NA = BM * 8 / NT, NB = 128 * 8 / NT, MI = BM / 128;
    constexpr int STAGE = (BM + 128) * 128;
    const int tid = tidx(), lane = tid & 63, r32 = lane & 31, hh = lane >> 5;
    const int w = __builtin_amdgcn_readfirstlane(tid >> 6), wr = w >> 1, wc = w & 1;
    const bf16_t* ap[NA];
    const bf16_t* bp[NB];
#pragma unroll
    for (int i = 0; i < NA; ++i) { const int p = tid + NT * i, row = p >> 3, cs = (p & 7) ^ ((row >> 1) & 7); ap[i] = af.row(m0 + row) + cs * 8; }
#pragma unroll
    for (int i = 0; i < NB; ++i) { const int p = tid + NT * i, row = p >> 3, cs = (p & 7) ^ ((row >> 1) & 7); bp[i] = Bt + (size_t)(n0 + row) * ldb + cs * 8; }
#pragma unroll
    for (int mi = 0; mi < MI; ++mi)
#pragma unroll
        for (int ni = 0; ni < 2; ++ni)
#pragma unroll
            for (int i = 0; i < 16; ++i) acc[mi][ni][i] = 0.f;
    const int nk = K / 64;
    const int xr = (r32 >> 1) & 7;
    const int arow = (wr * (BM / 4) + r32) * 128, brow = (wc * 64 + r32) * 128;
    auto stage = [&](int s, int kt) {
        LAS unsigned char* sa = lds + s * STAGE;
        LAS unsigned char* sb = sa + BM * 128;
#pragma unroll
        for (int i = 0; i < NA; ++i)
            __builtin_amdgcn_global_load_lds((const GAS void*)(ap[i] + kt * 64), (LAS void*)(sa + (w * 64 + NT * i) * 16), 16, 0, 0);
#pragma unroll
        for (int i = 0; i < NB; ++i)
            __builtin_amdgcn_global_load_lds((const GAS void*)(bp[i] + kt * 64), (LAS void*)(sb + (w * 64 + NT * i) * 16), 16, 0, 0);
    };
    stage(0, 0);
    for (int kt = 0; kt < nk; ++kt) {
        asm volatile("s_waitcnt vmcnt(0)" ::: "memory");
        __syncthreads();
        if (kt + 1 < nk) stage((kt + 1) & 1, kt + 1);
        LAS const unsigned char* sa = lds + (kt & 1) * STAGE;
        LAS const unsigned char* sb = sa + BM * 128;
#pragma unroll
        for (int kk = 0; kk < 4; ++kk) {
            const int co = (((kk * 2 + hh) ^ xr) << 4);
            bf16x8 a[MI], b[2];
#pragma unroll
            for (int mi = 0; mi < MI; ++mi) a[mi] = *(LAS const bf16x8*)(sa + arow + mi * 32 * 128 + co);
#pragma unroll
            for (int ni = 0; ni < 2; ++ni) b[ni] = *(LAS const bf16x8*)(sb + brow + ni * 32 * 128 + co);
#pragma unroll
            for (int mi = 0; mi < MI; ++mi)
#pragma unroll
                for (int ni = 0; ni < 2; ++ni) acc[mi][ni] = __builtin_amdgcn_mfma_f32_32x32x16_bf16(a[mi], b[ni], acc[mi][ni], 0, 0, 0);
        }
    }
    __syncthreads();
}

template <class EPI>
DI void staged_epilogue(LAS unsigned char* lds, f32x16 (&acc)[2][2], int m0, int n0, const EPI& epi) {
    const int tid = tidx(), lane = tid & 63, r32 = lane & 31, hh = lane >> 5;
    const int w = __builtin_amdgcn_readfirstlane(tid >> 6), wr = w >> 1, wc = w & 1;
    LAS float* st = (LAS float*)lds;
#pragma unroll
    for (int half = 0; half < 2; ++half) {
        if ((wr >> 1) == half) {
#pragma unroll
            for (int mi = 0; mi < 2; ++mi)
#pragma unroll
                for (int ni = 0; ni < 2; ++ni)
#pragma unroll
                    for (int i = 0; i < 16; ++i) st[((wr & 1) * 64 + mi * 32 + crow(i, hh)) * 132 + wc * 64 + ni * 32 + r32] = acc[mi][ni][i];
        }
        __syncthreads();
        {
            const int row = tid >> 2, ch = tid & 3;
            float v[32];
#pragma unroll
            for (int q = 0; q < 8; ++q) {
                const f32x4 t = *(LAS const f32x4*)(st + row * 132 + ch * 32 + q * 4);
                v[4 * q] = t[0]; v[4 * q + 1] = t[1]; v[4 * q + 2] = t[2]; v[4 * q + 3] = t[3];
            }
            epi(m0 + half * 128 + row, (n0 >> 5) + ch, v);
        }
        __syncthreads();
    }
}

DI void p0_mod_item(const Params& P, LAS unsigned char* lds, int item) {
    const int l = item / 48, n0 = (item % 48) * 64, tid = tidx();
    LAS float* sc = (LAS float*)lds;
    LAS float* red = sc + 5 * 1024;
    const float* c = P.in[8];
    const float* cctx = P.in[9];
    for (int idx = tid; idx < 5 * 1024; idx += NT) {
        const int j = idx >> 10, k = idx & 1023;
        const float x = (j == 0) ? cctx[k] : c[(j - 1) * 1024 + k];
        sc[idx] = x / (1.f + expf(-x));
    }
    __syncthreads();
    const int c4 = (tid & 15) * 4, kg = tid >> 4;
    const float* wp = P.in[10] + (size_t)l * 1024 * 3072 + (size_t)(kg * 32) * 3072 + n0 + c4;
    f32x4 a0 = {0.f, 0.f, 0.f, 0.f}, a1 = a0, a2 = a0, a3 = a0, a4 = a0;
#pragma unroll
    for (int h = 0; h < 2; ++h) {
        f32x4 w[16];
#pragma unroll
        for (int k = 0; k < 16; ++k) w[k] = *(const f32x4*)(wp + (size_t)(h * 16 + k) * 3072);
#pragma unroll
        for (int k = 0; k < 16; ++k) {
            const int kk = kg * 32 + h * 16 + k;
            a0 += sc[kk] * w[k]; a1 += sc[1024 + kk] * w[k]; a2 += sc[2048 + kk] * w[k]; a3 += sc[3072 + kk] * w[k]; a4 += sc[4096 + kk] * w[k];
        }
    }
    *(LAS f32x4*)(red + (kg * 5 + 0) * 64 + c4) = a0; *(LAS f32x4*)(red + (kg * 5 + 1) * 64 + c4) = a1; *(LAS f32x4*)(red + (kg * 5 + 2) * 64 + c4) = a2;
    *(LAS f32x4*)(red + (kg * 5 + 3) * 64 + c4) = a3; *(LAS f32x4*)(red + (kg * 5 + 4) * 64 + c4) = a4;
    __syncthreads();
    float* mod = (float*)(P.ws + WS_MOD);
    for (int idx = tid; idx < 320; idx += NT) {
        const int j = idx >> 6, cc = idx & 63;
        float s = P.in[11][l * 3072 + n0 + cc];
#pragma unroll 8
        for (int g = 0; g < 32; ++g) s += red[(g * 5 + j) * 64 + cc];
        mod[(l * 5 + j) * 3072 + n0 + cc] = s;
    }
    asm volatile("s_waitcnt vmcnt(0)" ::: "memory");
    __syncthreads();
    if (l == 0 && tid == 0) {
        __builtin_amdgcn_fence(__ATOMIC_RELEASE, "agent");
        asm volatile("s_waitcnt vmcnt(0)" ::: "memory");
        (void)__hip_atomic_fetch_add((unsigned*)(P.ws + WS_CTL) + CW_DEP, 1u, __ATOMIC_RELAXED, __HIP_MEMORY_SCOPE_AGENT);
    }
}

DI void p0_transpose_item(LAS unsigned char* lds, const float* src, int N, int k0, int ns0, int nvalid, bf16_t* dst, int ldd, int nd0, const float* kscale) {
    LAS float* T = (LAS float*)lds;
    const int tid = tidx();
#pragma unroll
    for (int i = 0; i < 2; ++i) {
        const int idx = tid + NT * i, kk = idx >> 4, n4 = (idx & 15) * 4;
        f32x4 v = {0.f, 0.f, 0.f, 0.f};
        if (n4 < nvalid) v = *(const f32x4*)(src + (size_t)(k0 + kk) * N + ns0 + n4);
        const float s = kscale ? kscale[k0 + kk] : 1.f;
        T[kk * 65 + n4] = v[0] * s; T[kk * 65 + n4 + 1] = v[1] * s; T[kk * 65 + n4 + 2] = v[2] * s; T[kk * 65 + n4 + 3] = v[3] * s;
    }
    __syncthreads();
    {
        const int idx = tid, nn = idx >> 3, kc = idx & 7;
        float v[8];
#pragma unroll
        for (int j = 0; j < 8; ++j) v[j] = T[(kc * 8 + j) * 65 + nn];
        u32x4 wv = {pk2(v[0], v[1]), pk2(v[2], v[3]), pk2(v[4], v[5]), pk2(v[6], v[7])};
        *(u32x4*)(dst + (size_t)(nd0 + nn) * ldd + k0 + kc * 8) = wv;
    }
    __syncthreads();
}

DI void p0_transpose_batch4(LAS unsigned char* lds, const float* src, int N, int k0, int jt0, int jmax, bool win, bf16_t* dst, int ldd) {
    LAS float* T = (LAS float*)lds;
    const int tid = tidx();
    f32x4 v[4][2];
#pragma unroll
    for (int q = 0; q < 4; ++q) {
        const int j = jt0 + q;
        const int ns0 = !win ? 64 * j : (j < 38) ? 64 * j : (j < 58 ? 64 * j + 32 : 2432), nvalid = (win && j == 58) ? 32 : 64;
#pragma unroll
        for (int i = 0; i < 2; ++i) {
            const int idx = tid + NT * i, kk = idx >> 4, n4 = (idx & 15) * 4;
            v[q][i] = (f32x4){0.f, 0.f, 0.f, 0.f};
            if (j < jmax && n4 < nvalid) v[q][i] = *(const f32x4*)(src + (size_t)(k0 + kk) * N + ns0 + n4);
        }
    }
#pragma unroll
    for (int q = 0; q < 4; ++q)
#pragma unroll
        for (int i = 0; i < 2; ++i) {
            const int idx = tid + NT * i, kk = idx >> 4, n4 = (idx & 15) * 4;
            LAS float* Tq = T + q * 64 * 65;
            Tq[kk * 65 + n4] = v[q][i][0]; Tq[kk * 65 + n4 + 1] = v[q][i][1]; Tq[kk * 65 + n4 + 2] = v[q][i][2]; Tq[kk * 65 + n4 + 3] = v[q][i][3];
        }
    __syncthreads();
#pragma unroll
    for (int q = 0; q < 4; ++q) {
        if (jt0 + q < jmax) {
            const int nn = tid >> 3, kc = tid & 7;
            LAS const float* Tq = T + q * 64 * 65;
            float w[8];
#pragma unroll
            for (int j = 0; j < 8; ++j) w[j] = Tq[(kc * 8 + j) * 65 + nn];
            u32x4 wv = {pk2(w[0], w[1]), pk2(w[2], w[3]), pk2(w[4], w[5]), pk2(w[6], w[7])};
            *(u32x4*)(dst + (size_t)((jt0 + q) * 64 + nn) * ldd + k0 + kc * 8) = wv;
        }
    }
    __syncthreads();
}

DI void p0_convert_flat(const float* src, bf16_t* dst, int item) {
    const size_t e = (size_t)item * 4096 + tidx() * 8;
    const f32x4 a = *(const f32x4*)(src + e), b = *(const f32x4*)(src + e + 4);
    u32x4 wv = {pk2(a[0], a[1]), pk2(a[2], a[3]), pk2(b[0], b[1]), pk2(b[2], b[3])};
    *(u32x4*)(dst + e) = wv;
}

DI void win_copy_item(const Params& P, LAS unsigned char* lds, int l, int r) {
    const int kt = r / 15, jb = r % 15;
    p0_transpose_batch4(lds, P.in[13] + (size_t)l * 1024 * 3744, 3744, kt * 64, jb * 4, 59, true, (bf16_t*)(P.ws + WS_WIN) + (size_t)l * NPADW * 1024, 1024);
}
DI void p0_convert_flat4(const float* src, bf16_t* dst) {
    const size_t e0 = (size_t)tidx() * 8;
    f32x4 a[4], b[4];
#pragma unroll
    for (int q = 0; q < 4; ++q) { a[q] = *(const f32x4*)(src + e0 + q * 4096); b[q] = *(const f32x4*)(src + e0 + q * 4096 + 4); }
#pragma unroll
    for (int q = 0; q < 4; ++q) {
        u32x4 wv = {pk2(a[q][0], a[q][1]), pk2(a[q][2], a[q][3]), pk2(b[q][0], b[q][1]), pk2(b[q][2], b[q][3])};
        *(u32x4*)(dst + e0 + q * 4096) = wv;
    }
}
constexpr int LP_WIN = 240, LP_WOUT = 64, LP_CA = 32, LP_CKV = 16, LP_KPE = 16, LP_TOTAL = LP_WIN + LP_WOUT + 4 * LP_CA + LP_CKV + LP_KPE;
DI void layer_prep_item(const Params& P, LAS unsigned char* lds, int l, int it) {
    if (it < LP_WIN) { win_copy_item(P, lds, l, it); return; }
    it -= LP_WIN;
    if (it < LP_WOUT) {
        const int kt = it >> 2, jb = it & 3;
        p0_transpose_batch4(lds, P.in[22] + (size_t)l * 1024 * 1024, 1024, kt * 64, jb * 4, 16, false, (bf16_t*)(P.ws + WS_WOUT) + (size_t)l * 1024 * 1024, 1024);
        return;
    }
    it -= LP_WOUT;
    if (it < 4 * LP_CA) {
        const int which = it >> 5, r = it & 31, b = r >> 3, sub = r & 7;
        const size_t off = (size_t)(b * 4 + l) * 131072 + (size_t)sub * 16384;
        if (which == 0) p0_convert_flat4(P.in[2] + off, (bf16_t*)(P.ws + WS_CAK) + off);
        else if (which == 1) p0_convert_flat4(P.in[3] + off, (bf16_t*)(P.ws + WS_CAV) + off);
        else if (which == 2) p0_convert_flat4(P.in[6] + off, (bf16_t*)(P.ws + WS_CDK) + off);
        else p0_convert_flat4(P.in[7] + off, (bf16_t*)(P.ws + WS_CDV) + off);
        return;
    }
    it -= 4 * LP_CA;
    if (it < LP_CKV) {
        const int b = it >> 2, sub = it & 3;
        const size_t off = (size_t)(b * 4 + l) * 65536 + (size_t)sub * 16384;
        p0_convert_flat4(P.in[4] + off, (bf16_t*)(P.ws + WS_CKVC) + off);
        return;
    }
    it -= LP_CKV;
    {
        const int b = it >> 2, sub = it & 3;
        const size_t e = (size_t)sub * 4096 + tidx() * 8;
        const float* src = P.in[5] + (size_t)(b * 4 + l) * 16384 + e;
        const f32x4 a = *(const f32x4*)(src), bq = *(const f32x4*)(src + 4);
        u32x4 wv = {pk2(a[0], a[1]), pk2(a[2], a[3]), pk2(bq[0], bq[1]), pk2(bq[2], bq[3])};
        const int j0 = (int)(e & 31), t = (int)(e >> 5);
        bf16_t* dst = (bf16_t*)(P.ws + WS_KCC) + ((size_t)(l * 4 + b) * 512 + t) * KCS + 64 + j0;
#pragma unroll
        for (int h = 0; h < 4; ++h) *(u32x4*)(dst + h * 160) = wv;
    }
}
constexpr int P0_MOD = 192, P0_WIN = 16 * 15  , P0_WOUT = 4 * 16 * 4, P0_WUQ = 4 * 4 * 6, P0_WUKV = 4 * 2 * 8,
              P0_CA = 512, P0_CKV = 256, P0_KPE = 64, P0_MISC = 1;
constexpr int P0_TOTAL = P0_MOD + P0_WIN + P0_WOUT + P0_WUQ + P0_WUKV + 4 * P0_CA + P0_CKV + P0_KPE + P0_MISC;

DI void phase0(const Params& P, LAS unsigned char* lds) {
    constexpr int P0_ALL = P0_MOD + LP_TOTAL + P0_WUQ + P0_WUKV + 1;
    for (int it = bidx(); it < P0_ALL; it += gridDim.x) {
        int item = it;
        if (item < P0_MOD) { p0_mod_item(P, lds, item); continue; }
        item -= P0_MOD;
        if (item < LP_TOTAL) { layer_prep_item(P, lds, 0, item); continue; }
        item -= LP_TOTAL;
        if (item < P0_WUQ) {
            const int l = item / 24, r = item % 24, kt = r / 6, j = r % 6;
            p0_transpose_item(lds, P.in[18] + (size_t)l * 256 * 384, 384, kt * 64, j * 64, 64, (bf16_t*)(P.ws + WS_WUQ) + (size_t)l * 384 * 256, 256, j * 64, P.in[17] + l * 256);
            continue;
        }
        item -= P0_WUQ;
        if (item < P0_WUKV) {
            const int l = item >> 4, r = item & 15, kt = r >> 3, j = r & 7;
            p0_transpose_item(lds, P.in[20] + (size_t)l * 128 * 512, 512, kt * 64, j * 64, 64, (bf16_t*)(P.ws + WS_WUKV) + (size_t)l * 512 * 128, 128, j * 64, nullptr);
            continue;
        }
        {
            const int tid = tidx();
            float* rope = (float*)(P.ws + WS_ROPE);
            for (int idx = tid; idx < 512; idx += NT) {
                const int pos = idx >> 3, i = idx & 7;
                const float inv = 1.0f / powf(10000.f, (float)(2 * i) / 16.f);
                const float ang = (float)pos * inv;
                rope[pos * 16 + i] = cosf(ang);
                rope[pos * 16 + 8 + i] = sinf(ang);
            }
            if (tid < 4) {
                const float* lv = P.in[14] + tid * 128;
                float s1 = 0.f, s2 = 0.f;
                for (int d = 0; d < 32; ++d) { s1 += lv[d] * lv[32 + d]; s2 += lv[64 + d] * lv[96 + d]; }
                const float li = 0.8f - 0.6f * expf(-0.3f * (float)tid);
                float* lam = (float*)(P.ws + WS_LAM);
                lam[tid * 2] = expf(s1) - expf(s2) + li;
                lam[tid * 2 + 1] = li;
            }
        }
    }
}

DI const float* xrow_ptr(const Params& P, int layer, int row) {
    if (layer == 0) return (row < NCTX) ? P.in[0] + (size_t)row * DM : P.in[1] + (size_t)(row - NCTX) * DM;
    return P.out + (size_t)row * DM;
}
DI void phaseN_rows(const Params& P, int layer, int row0, int rend, int rstep) {
    const int lane = tidx() & 63, w = tidx() >> 6;
    const float* g = P.in[12] + layer * DM;
    bf16_t* H = (bf16_t*)(P.ws + WS_H);
    for (int rb = row0; rb < rend; rb += rstep) {
        const int mi = (rb < NCTX) ? 0 : 1 + ((rb - NCTX) >> 11);
        const float* mod = (const float*)(P.ws + WS_MOD) + (size_t)(layer * 5 + mi) * 3072;
        f32x4 ca[4], cb[4];
#pragma unroll
        for (int i = 0; i < 4; ++i) {
            const int n = lane * 4 + 256 * i;
            const f32x4 gg = *(const f32x4*)(g + n), sc = *(const f32x4*)(mod + 1024 + n);
            cb[i] = *(const f32x4*)(mod + n);
            ca[i] = gg * (1.f + sc);
        }
        const int r4 = rb + 4 * w;
        f32x4 v[4][4];
        if (layer == 0) {
#pragma unroll
            for (int q = 0; q < 4; ++q) {
                const float* x = xrow_ptr(P, 0, r4 + q);
#pragma unroll
                for (int i = 0; i < 4; ++i) v[q][i] = *(const f32x4*)(x + lane * 4 + 256 * i);
            }
        } else {
            u32x2 xv[4][4];
#pragma unroll
            for (int q = 0; q < 4; ++q) {
                const bf16_t* x = (const bf16_t*)(P.ws + WS_XB) + (size_t)(r4 + q) * DM;
#pragma unroll
                for (int i = 0; i < 4; ++i) xv[q][i] = *(const u32x2*)(x + lane * 4 + 256 * i);
            }
#pragma unroll
            for (int q = 0; q < 4; ++q)
#pragma unroll
                for (int i = 0; i < 4; ++i) v[q][i] = (f32x4){bf2f(xv[q][i][0] & 0xffffu), bf2f(xv[q][i][0] >> 16), bf2f(xv[q][i][1] & 0xffffu), bf2f(xv[q][i][1] >> 16)};
        }
        float ss[4];
#pragma unroll
        for (int q = 0; q < 4; ++q) {
            float a = 0.f;
#pragma unroll
            for (int i = 0; i < 4; ++i) a += v[q][i][0] * v[q][i][0] + v[q][i][1] * v[q][i][1] + v[q][i][2] * v[q][i][2] + v[q][i][3] * v[q][i][3];
            ss[q] = a;
        }
#pragma unroll
        for (int o = 32; o >= 1; o >>= 1) {
#pragma unroll
            for (int q = 0; q < 4; ++q) ss[q] += shx(ss[q], o);
        }
#pragma unroll
        for (int q = 0; q < 4; ++q) {
            const float r = rsqrtf(ss[q] * (1.f / 1024.f) + eps_());
#pragma unroll
            for (int i = 0; i < 4; ++i) {
                const f32x4 o = v[q][i] * r * ca[i] + cb[i];
                u32x2 wv = {pk2(o[0], o[1]), pk2(o[2], o[3])};
                *(u32x2*)(H + (size_t)(r4 + q) * DM + lane * 4 + 256 * i) = wv;
            }
        }
    }
}
DI void phaseN(const Params& P, int layer) { phaseN_rows(P, layer, bidx() * 32, NTOK, gridDim.x * 32); }
DI void phaseFinal_rows(const Params& P, int row0, int rend, int rstep) {
    const int lane = tidx() & 63, w = tidx() >> 6;
    const float* g = P.in[23];
    f32x4 cg[4];
#pragma unroll
    for (int i = 0; i < 4; ++i) cg[i] = *(const f32x4*)(g + lane * 4 + 256 * i);
    for (int rb = row0; rb < rend; rb += rstep) {
        const int r4 = rb + 4 * w;
        f32x4 v[4][4];
#pragma unroll
        for (int q = 0; q < 4; ++q) {
            const float* x = P.out + (size_t)(r4 + q) * DM;
#pragma unroll
            for (int i = 0; i < 4; ++i) v[q][i] = *(const f32x4*)(x + lane * 4 + 256 * i);
        }
        float ss[4];
#pragma unroll
        for (int q = 0; q < 4; ++q) {
            float a = 0.f;
#pragma unroll
            for (int i = 0; i < 4; ++i) a += v[q][i][0] * v[q][i][0] + v[q][i][1] * v[q][i][1] + v[q][i][2] * v[q][i][2] + v[q][i][3] * v[q][i][3];
            ss[q] = a;
        }
#pragma unroll
        for (int o = 32; o >= 1; o >>= 1) {
#pragma unroll
            for (int q = 0; q < 4; ++q) ss[q] += shx(ss[q], o);
        }
#pragma unroll
        for (int q = 0; q < 4; ++q) {
            const float r = rsqrtf(ss[q] * (1.f / 1024.f) + eps_());
#pragma unroll
            for (int i = 0; i < 4; ++i) *(f32x4*)(P.out + (size_t)(r4 + q) * DM + lane * 4 + 256 * i) = v[q][i] * r * cg[i];
        }
    }
}

namespace pg8 {
#define PG8_LAS __attribute__((address_space(3)))
typedef unsigned short bf16_t;
typedef short bf16x8 __attribute__((ext_vector_type(8)));
typedef float f32x4 __attribute__((ext_vector_type(4)));
typedef unsigned u32x4 __attribute__((ext_vector_type(4)));
constexpr int BM = 256, BK = 64, HALF = 128, HTB = HALF * BK * 2  , STAGE_BYTES = 8 * HTB, NXCD = 8, WGM = 8;

__host__ __device__ __forceinline__ int lds_byte(int r, int c) { const int st = (r >> 4) * 2 + (c >> 5), rr = r & 15, cc = c & 31, ob = rr * 64 + cc * 2; return st * 1024 + (ob ^ (((ob >> 9) & 1) << 5)); }
__host__ __device__ __forceinline__ void stage_rc(int b, int& R, int& C) { const int st = b / 1024, sb = b % 1024, swz = sb ^ (((sb >> 9) & 1) << 5); R = (st >> 1) * 16 + swz / 64; C = (st & 1) * 32 + (swz % 64) / 2; }
__host__ __device__ __forceinline__ int perm32(int rho) { const int n = rho >> 4, i = rho & 15; return 8 * (i >> 2) + 4 * n + (i & 3); }

struct Unit { int pm, pn; };
struct Gemm { const bf16_t* A; const bf16_t* Bt; int M, N, K; int lda; };

struct StaticOrder {
    int nM, nN, nwg, G, c;
    __host__ __device__ void init(int M, int N, int G_, int c_) { nM = M / BM; nN = N / BM; nwg = nM * nN; G = G_; c = c_; }
    __host__ __device__ bool next(int i, Unit& u) const {
        const long L = (long)i * G + c; if (L >= nwg) return false;
        int wgid = (int)L; { const int q = nwg / NXCD, r = nwg % NXCD, xcd = wgid % NXCD, off = wgid / NXCD; wgid = (xcd < r ? xcd * (q + 1) : r * (q + 1) + (xcd - r) * q) + off; }
        const int nig = WGM * nN, gid = wgid / nig, fm = gid * WGM, gsz = (nM - fm) < WGM ? (nM - fm) : WGM;
        u.pm = fm + ((wgid % nig) % gsz); u.pn = (wgid % nig) / gsz; return true;
    }
    __device__ __forceinline__ void a_ready(const Unit&) const {}
    __device__ __forceinline__ void done(const Unit&) const {}
};

template <class Epi, class Sched, bool ALIGN_EPI = false, bool SP2 = false>
__device__ __forceinline__ void gemm_phase(PG8_LAS unsigned char* lds, const Gemm g, const Sched& S, const Epi& E) {
    const int tid = tidx(), wid = __builtin_amdgcn_readfirstlane(tid >> 6), lane = tid & 63, wr = wid >> 2, wc = wid & 3, fr = lane & 15, fq = lane >> 4;
    const int K = g.K, nt = K / BK, LDA = g.lda ? g.lda : g.K;
    unsigned voffA[2], voffB[2];
#pragma unroll
    for (int i = 0; i < 2; ++i) { int R, C; stage_rc(tid * 16 + i * 8192, R, C); const int Rb = Epi::PERM ? ((R & ~31) + perm32(R & 31)) : R;
        voffA[i] = (unsigned)(R * LDA + C) * 2u; voffB[i] = (unsigned)(Rb * K + C) * 2u; }
    const size_t kstep = (size_t)(BK * 2);
    const size_t hstepB = (size_t)HALF * K * 2, hstepA = (size_t)HALF * LDA * 2;
    const size_t tstepB = 2 * hstepB, tstepA = 2 * hstepA;
    const unsigned ldsw = (unsigned)wid * 1024u;
    const int aoff = lds_byte(wr * 64 + fr, fq * 8), boff = lds_byte(wc * 32 + fr, fq * 8);
#define PG8_SA(b, h) (((b) * 2 + (h)) * HTB)
#define PG8_SB(b, h) ((4 + (b) * 2 + (h)) * HTB)
#define PG8_STAGE(bufoff, gbase, voff) do { _Pragma("unroll") for (int _i = 0; _i < 2; ++_i) \
        __builtin_amdgcn_global_load_lds((const unsigned*)((const char*)(gbase) + (voff)[_i]), (PG8_LAS unsigned*)(lds + (bufoff) + ldsw + _i * 8192), 16, 0, 0); } while (0)
#define PG8_LDA(dst, b, h) do { _Pragma("unroll") for (int m = 0; m < 4; ++m) _Pragma("unroll") for (int k = 0; k < 2; ++k) dst[m][k] = *(const PG8_LAS bf16x8*)(lds + PG8_SA(b, h) + aoff + m * 2048 + k * 1024); } while (0)
#define PG8_LDB(dst, b, h) do { _Pragma("unroll") for (int n = 0; n < 2; ++n) _Pragma("unroll") for (int k = 0; k < 2; ++k) dst[n][k] = *(const PG8_LAS bf16x8*)(lds + PG8_SB(b, h) + boff + n * 2048 + k * 1024); } while (0)
#define PG8_MMA(ai, bj, At, Bt) do { __builtin_amdgcn_s_setprio(1); _Pragma("unroll") for (int m = 0; m < 4; ++m) _Pragma("unroll") for (int n = 0; n < 2; ++n) _Pragma("unroll") for (int k = 0; k < 2; ++k) \
        acc[ai][bj][m][n] = __builtin_amdgcn_mfma_f32_16x16x32_bf16(Bt[n][k], At[m][k], acc[ai][bj][m][n], 0, 0, 0); __builtin_amdgcn_s_setprio(0); } while (0)
#define PG8_WAIT_V(n) asm volatile("s_waitcnt vmcnt(" #n ")" ::: "memory")
#define PG8_WAIT_L(n) asm volatile("s_waitcnt lgkmcnt(" #n ")" ::: "memory")
#define PG8_BAR __builtin_amdgcn_s_barrier()
#define PG8_SCHED __builtin_amdgcn_sched_barrier(0)
    Unit cur, nxt; int ui = 0;
    if (!S.next(0, cur)) return;
    f32x4 acc[2][2][4][2];
#pragma unroll
    for (int a = 0; a < 2; ++a)
#pragma unroll
        for (int b = 0; b < 2; ++b)
#pragma unroll
            for (int m = 0; m < 4; ++m)
#pragma unroll
                for (int n = 0; n < 2; ++n) acc[a][b][m][n] = (f32x4){0.f, 0.f, 0.f, 0.f};
    bf16x8 At[4][2], B0[2][2], B1[2][2];
    const char* cA = (const char*)g.A + (size_t)cur.pm * tstepA; const char* cB = (const char*)g.Bt + (size_t)cur.pn * tstepB;
    S.a_ready(cur);
    if constexpr (SP2) {
        PG8_STAGE(PG8_SB(0, 0), cB, voffB); PG8_STAGE(PG8_SB(0, 1), cB + hstepB, voffB); PG8_STAGE(PG8_SA(0, 0), cA, voffA); PG8_STAGE(PG8_SA(0, 1), cA + hstepA, voffA);
        if (wr == 1) PG8_BAR;
        PG8_WAIT_V(2); PG8_BAR;
        PG8_STAGE(PG8_SB(1, 0), cB + kstep, voffB); PG8_STAGE(PG8_SA(1, 0), cA + kstep, voffA); PG8_STAGE(PG8_SB(1, 1), cB + hstepB + kstep, voffB);
        PG8_WAIT_V(6); PG8_BAR;
    } else {
        PG8_STAGE(PG8_SB(0, 0), cB, voffB); PG8_STAGE(PG8_SA(0, 0), cA, voffA); PG8_STAGE(PG8_SB(0, 1), cB + hstepB, voffB); PG8_STAGE(PG8_SA(0, 1), cA + hstepA, voffA);
        if (wr == 1) PG8_BAR;
        PG8_WAIT_V(4); PG8_BAR;
        PG8_STAGE(PG8_SB(1, 0), cB + kstep, voffB); PG8_STAGE(PG8_SA(1, 0), cA + kstep, voffA); PG8_STAGE(PG8_SB(1, 1), cB + hstepB + kstep, voffB);
        PG8_WAIT_V(6); PG8_BAR;
    }
    for (;;) {
        const bool has_next = S.next(ui + 1, nxt);
        const char* nA = has_next ? (const char*)g.A + (size_t)nxt.pm * tstepA : cA; const char* nB = has_next ? (const char*)g.Bt + (size_t)nxt.pn * tstepB : cB;
        for (int t = 0; t < nt; t += 2) {
            const bool last = (t == nt - 2);
            const char* a1 = cA + (size_t)(t + 1) * kstep;
            const char* a2 = last ? nA : cA + (size_t)(t + 2) * kstep; const char* b2 = last ? nB : cB + (size_t)(t + 2) * kstep;
            const char* a3 = a2 + kstep; const char* b3 = b2 + kstep;
            if (last && has_next) S.a_ready(nxt);
            if constexpr (SP2) {
            PG8_LDB(B0, 0, 0); PG8_LDB(B1, 0, 1); PG8_SCHED; PG8_LDA(At, 0, 0); PG8_STAGE(PG8_SA(1, 1), a1 + hstepA, voffA);
            PG8_WAIT_V(8); PG8_WAIT_L(0); PG8_BAR; PG8_MMA(0, 0, At, B0); PG8_MMA(0, 1, At, B1); PG8_BAR; PG8_SCHED;
            PG8_LDA(At, 0, 1); PG8_STAGE(PG8_SB(0, 0), b2, voffB); PG8_STAGE(PG8_SB(0, 1), b2 + hstepB, voffB); PG8_STAGE(PG8_SA(0, 0), a2, voffA);
            PG8_WAIT_V(8); PG8_WAIT_L(0); PG8_BAR; PG8_MMA(1, 0, At, B0); PG8_MMA(1, 1, At, B1); PG8_BAR; PG8_SCHED;
            PG8_LDB(B0, 1, 0); PG8_LDB(B1, 1, 1); PG8_SCHED; PG8_LDA(At, 1, 0); PG8_STAGE(PG8_SA(0, 1), a2 + hstepA, voffA);
            PG8_WAIT_V(8); PG8_WAIT_L(0); PG8_BAR; PG8_MMA(0, 0, At, B0); PG8_MMA(0, 1, At, B1); PG8_BAR; PG8_SCHED;
            PG8_LDA(At, 1, 1); PG8_STAGE(PG8_SB(1, 0), b3, voffB); PG8_STAGE(PG8_SB(1, 1), b3 + hstepB, voffB); PG8_STAGE(PG8_SA(1, 0), a3, voffA);
            PG8_WAIT_V(8); PG8_WAIT_L(0); PG8_BAR; PG8_MMA(1, 0, At, B0); PG8_MMA(1, 1, At, B1); PG8_BAR; PG8_SCHED;
            } else {
            PG8_LDB(B0, 0, 0); PG8_SCHED; PG8_LDA(At, 0, 0); PG8_STAGE(PG8_SA(1, 1), a1 + hstepA, voffA);
            PG8_WAIT_L(8); PG8_BAR; PG8_WAIT_L(0); PG8_MMA(0, 0, At, B0); PG8_BAR; PG8_SCHED;
            PG8_LDB(B1, 0, 1); PG8_STAGE(PG8_SB(0, 0), b2, voffB);
            PG8_BAR; PG8_WAIT_L(0); PG8_MMA(0, 1, At, B1); PG8_BAR;
            PG8_LDA(At, 0, 1); PG8_STAGE(PG8_SA(0, 0), a2, voffA);
            PG8_BAR; PG8_WAIT_L(0); PG8_MMA(1, 0, At, B0); PG8_BAR; PG8_SCHED;
            PG8_STAGE(PG8_SB(0, 1), b2 + hstepB, voffB);
            PG8_WAIT_V(6); PG8_BAR; PG8_MMA(1, 1, At, B1); PG8_BAR;
            PG8_LDB(B0, 1, 0); PG8_SCHED; PG8_LDA(At, 1, 0); PG8_STAGE(PG8_SA(0, 1), a2 + hstepA, voffA);
            PG8_WAIT_L(8); PG8_BAR; PG8_WAIT_L(0); PG8_MMA(0, 0, At, B0); PG8_BAR; PG8_SCHED;
            PG8_LDB(B1, 1, 1); PG8_STAGE(PG8_SB(1, 0), b3, voffB);
            PG8_BAR; PG8_WAIT_L(0); PG8_MMA(0, 1, At, B1); PG8_BAR;
            PG8_LDA(At, 1, 1); PG8_STAGE(PG8_SA(1, 0), a3, voffA);
            PG8_BAR; PG8_WAIT_L(0); PG8_MMA(1, 0, At, B0); PG8_BAR; PG8_SCHED;
            PG8_STAGE(PG8_SB(1, 1), b3 + hstepB, voffB);
            PG8_WAIT_V(6); PG8_BAR; PG8_MMA(1, 1, At, B1); PG8_BAR;
            }
        }
        if constexpr (ALIGN_EPI) { if (wr == 0) PG8_BAR; }
        if constexpr (!Epi::AFTER_DRAIN) { E(acc, cur, wr, wc, fr, fq); S.done(cur); }
        if (!has_next) break;
#pragma unroll
        for (int a = 0; a < 2; ++a)
#pragma unroll
            for (int b = 0; b < 2; ++b)
#pragma unroll
                for (int m = 0; m < 4; ++m)
#pragma unroll
                    for (int n = 0; n < 2; ++n) acc[a][b][m][n] = (f32x4){0.f, 0.f, 0.f, 0.f};
        cur = nxt; cA = nA; cB = nB; ++ui;
        if constexpr (ALIGN_EPI) { if (wr == 1) PG8_BAR; }
    }
    PG8_WAIT_V(0);
    if constexpr (!ALIGN_EPI) { if (wr == 0) PG8_BAR; }
    PG8_BAR;
    if constexpr (Epi::AFTER_DRAIN) { E.fused(acc, cur, wr, wc, fr, fq, lds, wid, lane); S.done(cur); }
#undef PG8_SA
#undef PG8_SB
#undef PG8_STAGE
#undef PG8_LDA
#undef PG8_LDB
#undef PG8_MMA
#undef PG8_WAIT_V
#undef PG8_WAIT_L
#undef PG8_BAR
#undef PG8_SCHED
}
}


struct EpiP1G {
    static constexpr bool PERM = true, AFTER_DRAIN = false;
    const Params* pp; int l; LAS float* xl;
    static constexpr int ROPE_LDS = 139264;
    static DI void st8(bf16_t* p, const float* v) { u32x4 w = {pk2(v[0], v[1]), pk2(v[2], v[3]), pk2(v[4], v[5]), pk2(v[6], v[7])}; *(u32x4*)p = w; }
    static DI void st8wt(bf16_t* p, const float* v) { u32x4 w = {pk2(v[0], v[1]), pk2(v[2], v[3]), pk2(v[4], v[5]), pk2(v[6], v[7])}; asm volatile("global_store_dwordx4 %0, %1, off sc1\n\ts_nop 1" :: "v"(p), "v"(w) : "memory"); }
    static DI void sf8(float* p, const float* v) { f32x4 a = {v[0], v[1], v[2], v[3]}, b = {v[4], v[5], v[6], v[7]}; *(f32x4*)p = a; *(f32x4*)(p + 4) = b; }
    DI void rope8(float* v, int t, int fq) const {
        LAS const float* tb = (LAS const float*)(xl + (ROPE_LDS - 131072) / 4) + ((fq >> 1) ? (t & 63) : (t >> 6)) * 16;
        const f32x4 c0 = *(LAS const f32x4*)tb, c1 = *(LAS const f32x4*)(tb + 4), s0 = *(LAS const f32x4*)(tb + 8), s1 = *(LAS const f32x4*)(tb + 12);
#pragma unroll
        for (int j = 0; j < 8; ++j) {
            const float pv = shx(v[j], 16);
            const float c = j < 4 ? c0[j & 3] : c1[j & 3], sn = j < 4 ? s0[j & 3] : s1[j & 3];
            v[j] = (fq & 1) ? v[j] * c + pv * sn : v[j] * c - pv * sn;
        }
    }
    static DI unsigned bperm(int a, unsigned v) { return (unsigned)__builtin_amdgcn_ds_bpermute(a, (int)v); }
    static DI u32x4 pack8t(const float* v, int bsrc) {
        u32x4 w = {pk2(v[0], v[1]), pk2(v[2], v[3]), pk2(v[4], v[5]), pk2(v[6], v[7])};
        u32x4 o = {bperm(bsrc, w[0]), bperm(bsrc, w[1]), bperm(bsrc, w[2]), bperm(bsrc, w[3])};
        return o;
    }
    static DI void st8t(bf16_t* p, const float* v, int bsrc) { *(u32x4*)p = pack8t(v, bsrc); }
    static DI void st8wtt(bf16_t* p, const float* v, int bsrc) { const u32x4 w = pack8t(v, bsrc); asm volatile("global_store_dwordx4 %0, %1, off sc1\n\ts_nop 1" :: "v"(p), "v"(w) : "memory"); }
    static DI void sf8t(float* p, const float* v, int bsrc) {
        f32x4 a, b;
#pragma unroll
        for (int j = 0; j < 4; ++j) { a[j] = __uint_as_float(bperm(bsrc, __float_as_uint(v[j]))); b[j] = __uint_as_float(bperm(bsrc, __float_as_uint(v[4 + j]))); }
        *(f32x4*)p = a; *(f32x4*)(p + 4) = b;
    }
    template <int CLS, int BJ>
    DI void rows(const pg8::f32x4 (&acc)[2][2][4][2], const pg8::Unit& u, int wr, int wc, int fr, int fq, int c32) const {
        const bool lat = u.pm >= 16;
        bf16_t* const U = (bf16_t*)(pp->ws + WS_U); bf16_t* const KC = (bf16_t*)(pp->ws + WS_KC); float* const SSQ = (float*)(pp->ws + WS_SSQ);
        float* const out = pp->out; const float* const gkv = pp->in[19] + l * 128;
        (void)U; (void)KC; (void)SSQ; (void)out; (void)gkv;
        const int ln = fq * 16 + fr, fr2 = ln >> 2, fq2 = ln & 3, bsrc = (fq2 * 16 + fr2) * 4;
        if constexpr (CLS == 6) {
            if constexpr (BJ == 0) {
#pragma unroll
                for (int ai = 0; ai < 2; ++ai)
#pragma unroll
                    for (int m = 0; m < 4; ++m) {
                        const int rloc = ai * 128 + wr * 64 + m * 16 + fr;
                        float ss = 0.f;
#pragma unroll
                        for (int j = 0; j < 4; ++j) ss += acc[ai][BJ][m][0][j] * acc[ai][BJ][m][0][j] + acc[ai][BJ][m][1][j] * acc[ai][BJ][m][1][j];
                        ss += shx(ss, 16); ss += shx(ss, 32);
                        if (fq == 0) xl[rloc * 4 + wc] = ss;
                    }
                asm volatile("s_waitcnt lgkmcnt(0)" ::: "memory"); __builtin_amdgcn_s_barrier(); asm volatile("" ::: "memory");
                const float* gp = gkv + (c32 - 72) * 32 + fq * 8;
                const f32x4 g0 = *(const f32x4*)gp, g1 = *(const f32x4*)(gp + 4);
#pragma unroll
                for (int ai = 0; ai < 2; ++ai)
#pragma unroll
                    for (int m = 0; m < 4; ++m) {
                        const int rb = ai * 128 + wr * 64 + m * 16, rloc = rb + fr, rloc2 = rb + fr2;
                        const f32x4 pp = *(LAS const f32x4*)(xl + rloc * 4);
                        const float rr = rsqrtf((pp[0] + pp[1] + pp[2] + pp[3]) * (1.f / 128.f) + eps_());
                        float v[8];
#pragma unroll
                        for (int j = 0; j < 4; ++j) { v[j] = acc[ai][BJ][m][0][j] * rr * g0[j]; v[4 + j] = acc[ai][BJ][m][1][j] * rr * g1[j]; }
                        if (!lat) sf8t(out + O_SCKV + ((size_t)(u.pm * 4 + l) * 256 + rloc2) * 128 + (c32 - 72) * 32 + fq2 * 8, v, bsrc);
                        st8wtt(U + (size_t)(u.pm * 256 + rloc2) * USTR + c32 * 32 + fq2 * 8, v, bsrc);
                        asm volatile("" ::: "memory");
                    }
                asm volatile("s_waitcnt lgkmcnt(0)" ::: "memory"); __builtin_amdgcn_s_barrier(); asm volatile("" ::: "memory");
            }
        } else {
#pragma unroll
            for (int ai = 0; ai < 2; ++ai)
#pragma unroll
                for (int m = 0; m < 4; ++m) {
                    const int rb = ai * 128 + wr * 64 + m * 16, rloc = rb + fr, r = u.pm * 256 + rloc, rloc2 = rb + fr2, r2 = u.pm * 256 + rloc2;
                    float v[8];
#pragma unroll
                    for (int j = 0; j < 4; ++j) { v[j] = acc[ai][BJ][m][0][j]; v[4 + j] = acc[ai][BJ][m][1][j]; }
                    bf16_t* up = U + (size_t)r2 * USTR + c32 * 32 + fq2 * 8;
                    const int t = (r - NCTX) & 2047;
                    const size_t srow = (size_t)(u.pm * 4 + l) * 256 + rloc2;
                    if constexpr (CLS == 0) {
                        if (lat) rope8(v, t, fq);
#pragma unroll
                        for (int j = 0; j < 8; ++j) v[j] *= SC_A;
                        st8t(up, v, bsrc);
                    } else if constexpr (CLS == 1) {
                        if (lat) rope8(v, t, fq); else sf8t(out + O_SAK + srow * 256 + (c32 - 8) * 32 + fq2 * 8, v, bsrc);
                        st8t(up, v, bsrc);
                    } else if constexpr (CLS == 2) {
                        if (!lat) sf8t(out + O_SAV + srow * 256 + (c32 - 16) * 32 + fq2 * 8, v, bsrc);
                        st8t(up, v, bsrc);
                    } else if constexpr (CLS == 3) {
#pragma unroll
                        for (int j = 0; j < 8; ++j) v[j] = siluf(v[j]);
                        st8t(up, v, bsrc);
                    } else if constexpr (CLS == 4) {
                        st8t(up, v, bsrc);
                    } else if constexpr (CLS == 5) {
                        float ss = 0.f;
#pragma unroll
                        for (int j = 0; j < 8; ++j) ss += v[j] * v[j];
                        ss += shx(ss, 16); ss += shx(ss, 32);
                        if (fq == 0) __hip_atomic_store((unsigned*)(SSQ + (size_t)r * 8 + (c32 - 64)), __float_as_uint(ss), __ATOMIC_RELAXED, __HIP_MEMORY_SCOPE_AGENT);
                        st8wtt(up, v, bsrc);
                    } else if constexpr (CLS == 7) {
#pragma unroll
                        for (int j = 0; j < 8; ++j) v[j] *= SC_D;
                        st8t(up, v, bsrc);
                    } else if constexpr (CLS == 8) {
                        if (!lat) sf8t(out + O_SDK + srow * 256 + (c32 - 92) * 32 + fq2 * 8, v, bsrc);
                        st8t(up, v, bsrc);
                    } else if constexpr (CLS == 9) {
                        if (!lat) sf8t(out + O_SDV + srow * 256 + (c32 - 100) * 32 + fq2 * 8, v, bsrc);
                        st8t(up, v, bsrc);
                    } else if constexpr (CLS == 10) {
                        if (lat) rope8(v, t, fq); else sf8t(out + O_SKPE + srow * 32 + fq2 * 8, v, bsrc);
                        bf16_t* kr = KC + (size_t)r2 * KCS + 64 + fq2 * 8;
                        const u32x4 w = pack8t(v, bsrc);
#pragma unroll
                        for (int h = 0; h < 4; ++h) *(u32x4*)(kr + h * 160) = w;
                    }
                    asm volatile("" ::: "memory");
                }
        }
    }
    template <int BJ>
    DI void half(const pg8::f32x4 (&acc)[2][2][4][2], const pg8::Unit& u, int wr, int wc, int fr, int fq) const {
        const int c32 = u.pn * 8 + BJ * 4 + wc;
        if (c32 < 8) rows<0, BJ>(acc, u, wr, wc, fr, fq, c32);
        else if (c32 < 16) rows<1, BJ>(acc, u, wr, wc, fr, fq, c32);
        else if (c32 < 24) rows<2, BJ>(acc, u, wr, wc, fr, fq, c32);
        else if (c32 < 32 || (c32 >= 56 && c32 < 64) || (c32 >= 76 && c32 < 84) || (c32 >= 108 && c32 < 116)) rows<3, BJ>(acc, u, wr, wc, fr, fq, c32);
        else if (c32 < 56) rows<4, BJ>(acc, u, wr, wc, fr, fq, c32);
        else if (c32 < 72) rows<5, BJ>(acc, u, wr, wc, fr, fq, c32);
        else if (c32 < 76) rows<6, BJ>(acc, u, wr, wc, fr, fq, c32);
        else if (c32 < 92) rows<7, BJ>(acc, u, wr, wc, fr, fq, c32);
        else if (c32 < 100) rows<8, BJ>(acc, u, wr, wc, fr, fq, c32);
        else if (c32 < 108) rows<9, BJ>(acc, u, wr, wc, fr, fq, c32);
        else if (c32 == 116) rows<10, BJ>(acc, u, wr, wc, fr, fq, c32);
    }
    DI void operator()(const pg8::f32x4 (&acc)[2][2][4][2], const pg8::Unit& u, int wr, int wc, int fr, int fq) const {
        asm volatile("" : "+v"(fr), "+v"(fq));
        half<0>(acc, u, wr, wc, fr, fq);
        half<1>(acc, u, wr, wc, fr, fq);
    }
};


DI void store16_wt(void* p, f32x4 v) { asm volatile("global_store_dwordx4 %0, %1, off sc1\n\ts_nop 1" :: "v"(p), "v"(v)); }
DI void dep_signal(unsigned* ctr) {
    asm volatile("s_waitcnt vmcnt(0)" ::: "memory");
    __syncthreads();
    if (tidx() == 0) (void)__hip_atomic_fetch_add(ctr, 1u, __ATOMIC_RELAXED, __HIP_MEMORY_SCOPE_AGENT);
}
DI void dep_wait(unsigned* ctr, unsigned target) {
    if (tidx() == 0) {
        unsigned sp = 0;
        while (__hip_atomic_load(ctr, __ATOMIC_RELAXED, __HIP_MEMORY_SCOPE_AGENT) < target) {
            __builtin_amdgcn_s_sleep(2);
            if (++sp > (1u << 22)) break;
        }
        __builtin_amdgcn_fence(__ATOMIC_ACQUIRE, "agent");
        asm volatile("s_waitcnt vmcnt(0)" ::: "memory");
    }
    __syncthreads();
}

struct EpiP3G {
    static constexpr bool PERM = true, AFTER_DRAIN = false;
    const Params* pp; int layer;
    DI void operator()(const pg8::f32x4 (&acc)[2][2][4][2], const pg8::Unit& u, int wr, int wc, int fr, int fq) const {
        asm volatile("" : "+v"(fr), "+v"(fq));
        const float* const x0c = pp->in[0]; const float* const x0l = pp->in[1]; float* const out = pp->out; const float* const mod = (const float*)(pp->ws + WS_MOD);
        const int mi = (u.pm < 16) ? 0 : 1 + ((u.pm - 16) >> 3);
        const float* gate = mod + (size_t)(layer * 5 + mi) * 3072 + 2048;
#pragma unroll
        for (int bj = 0; bj < 2; ++bj) {
            const int c8 = u.pn * 256 + bj * 128 + wc * 32 + fq * 8;
            const f32x4 g0 = *(const f32x4*)(gate + c8), g1 = *(const f32x4*)(gate + c8 + 4);
#pragma unroll
            for (int ai = 0; ai < 2; ++ai)
#pragma unroll
                for (int m = 0; m < 4; ++m) {
                    const int r = u.pm * 256 + ai * 128 + wr * 64 + m * 16 + fr;
                    bf16_t* const xb = (bf16_t*)(pp->ws + WS_XB) + (size_t)r * DM + c8;
                    f32x4 a, b;
                    if (layer == 0) {
                        const float* xin = (r < NCTX) ? x0c + (size_t)r * DM : x0l + (size_t)(r - NCTX) * DM;
                        a = *(const f32x4*)(xin + c8); b = *(const f32x4*)(xin + c8 + 4);
                    } else {
                        const u32x4 xv = *(const u32x4*)xb;
                        a = (f32x4){bf2f(xv[0] & 0xffffu), bf2f(xv[0] >> 16), bf2f(xv[1] & 0xffffu), bf2f(xv[1] >> 16)};
                        b = (f32x4){bf2f(xv[2] & 0xffffu), bf2f(xv[2] >> 16), bf2f(xv[3] & 0xffffu), bf2f(xv[3] >> 16)};
                    }
                    a = a + g0 * acc[ai][bj][m][0]; b = b + g1 * acc[ai][bj][m][1];
                    if (layer + 1 < DEPTH) {
                        u32x4 wv = {pk2(a[0], a[1]), pk2(a[2], a[3]), pk2(b[0], b[1]), pk2(b[2], b[3])};
                        *(u32x4*)xb = wv;
                    } else {
                        *(f32x4*)(out + (size_t)r * DM + c8) = a;
                        *(f32x4*)(out + (size_t)r * DM + c8 + 4) = b;
                    }
                }
        }
    }
};

struct ARowPlain { const bf16_t* base; int ld; DI const bf16_t* row(int m) const { return base + (size_t)m * ld; } };

struct EpiP1 {
    bf16_t* U; bf16_t* KC; float* SSQ; const float* rope; float* out; const float* gkv; int l;
    DI void operator()(int m, int c32, float* v) const {
        const bool lat = (m >= NCTX);
        const int t = (m - NCTX) & 2047;
        const size_t srow = lat ? 0 : ((size_t)((m >> 8) * 4 + l) * 256 + (m & 255));
        bf16_t* urow = U + (size_t)m * USTR + c32 * 32;
        if (c32 < 8) {
            if (lat) rope32(v, rope, t);
#pragma unroll
            for (int j = 0; j < 32; ++j) v[j] *= SC_A;
            store_bf16x32(urow, v);
        } else if (c32 < 16) {
            if (lat) rope32(v, rope, t); else store_f32x32(out + O_SAK + srow * 256 + (c32 - 8) * 32, v);
            store_bf16x32(urow, v);
        } else if (c32 < 24) {
            if (!lat) store_f32x32(out + O_SAV + srow * 256 + (c32 - 16) * 32, v);
            store_bf16x32(urow, v);
        } else if (c32 < 32 || (c32 >= 56 && c32 < 64) || (c32 >= 76 && c32 < 84) || (c32 >= 108 && c32 < 116)) {
#pragma unroll
            for (int j = 0; j < 32; ++j) v[j] = siluf(v[j]);
            store_bf16x32(urow, v);
        } else if (c32 < 56) {
            store_bf16x32(urow, v);
        } else if (c32 < 72) {
            float ss = 0.f;
#pragma unroll
            for (int j = 0; j < 32; ++j) ss += v[j] * v[j];
            SSQ[(size_t)m * 8 + (c32 - 64)] = ss;
            store_bf16x32(urow, v);
        } else if (c32 < 76) {
            float ss = 0.f;
#pragma unroll
            for (int j = 0; j < 32; ++j) ss += v[j] * v[j];
            ss += shx(ss, 1);
            ss += shx(ss, 2);
            const float r = rsqrtf(ss * (1.f / 128.f) + eps_());
            const float* gp = gkv + (c32 - 72) * 32;
#pragma unroll
            for (int j = 0; j < 32; ++j) v[j] = v[j] * r * gp[j];
            if (!lat) store_f32x32(out + O_SCKV + srow * 128 + (c32 - 72) * 32, v);
            store_bf16x32(urow, v);
        } else if (c32 < 92) {
#pragma unroll
            for (int j = 0; j < 32; ++j) v[j] *= SC_D;
            store_bf16x32(urow, v);
        } else if (c32 < 100) {
            if (!lat) store_f32x32(out + O_SDK + srow * 256 + (c32 - 92) * 32, v);
            store_bf16x32(urow, v);
        } else if (c32 < 108) {
            if (!lat) store_f32x32(out + O_SDV + srow * 256 + (c32 - 100) * 32, v);
            store_bf16x32(urow, v);
        } else if (c32 == 116) {
            if (lat) rope32(v, rope, t); else store_f32x32(out + O_SKPE + srow * 32, v);
            bf16_t* kr = KC + (size_t)m * KCS + 64;
#pragma unroll
            for (int h = 0; h < 4; ++h) store_bf16x32(kr + h * 160, v);
        }
    }
};

struct P1Order {
    int G, c; unsigned* dep;
    DI bool next(int i, pg8::Unit& u) const {
        const int L = i * G + c;
        if (L < 96) { u.pm = L >> 1; u.pn = 8 + (L & 1); return true; }
        const int L2 = L - 96;
        if (L2 >= 624) return false;
        constexpr int nM = 48, nN = 13, nwg = 624, NX = 8, WG = 8;
        int wgid = L2; { const int q = nwg / NX, xcd = wgid % NX, off = wgid / NX; wgid = xcd * q + off; }
        const int nig = WG * nN, gid = wgid / nig, fm = gid * WG, gsz = (nM - fm) < WG ? (nM - fm) : WG;
        u.pm = fm + ((wgid % nig) % gsz);
        const int pn = (wgid % nig) / gsz;
        u.pn = pn < 8 ? pn : pn + 2;
        return true;
    }
    DI void a_ready(const pg8::Unit&) const {}
    DI void done(const pg8::Unit& u) const {
        if (u.pn == 8 || u.pn == 9) {
            asm volatile("s_waitcnt vmcnt(0)" ::: "memory");
            __builtin_amdgcn_s_barrier();
            if (tidx() == 0) (void)__hip_atomic_fetch_add(dep + u.pm, 1u, __ATOMIC_RELAXED, __HIP_MEMORY_SCOPE_AGENT);
        }
    }
};
struct OneUnit {
    int pn;
    DI bool next(int i, pg8::Unit& u) const { if (i) return false; u.pm = 0; u.pn = pn; return true; }
    DI void a_ready(const pg8::Unit&) const {}
    DI void done(const pg8::Unit&) const {}
};
struct EpiQG {
    static constexpr bool PERM = true, AFTER_DRAIN = false;
    const Params* pp; int row0; LAS const float* rope;
    DI void operator()(const pg8::f32x4 (&acc)[2][2][4][2], const pg8::Unit& u, int wr, int wc, int fr, int fq) const {
        asm volatile("" : "+v"(fr), "+v"(fq));
        bf16_t* const QC = (bf16_t*)(pp->ws + WS_QC); const float* const SSQ = (const float*)(pp->ws + WS_SSQ);
#pragma unroll
        for (int bj = 0; bj < 2; ++bj) {
            const int c32 = u.pn * 8 + bj * 4 + wc;
            if (c32 < 12) {
                const bool ropec = (c32 % 3) == 2;
#pragma unroll
                for (int ai = 0; ai < 2; ++ai)
#pragma unroll
                    for (int m = 0; m < 4; ++m) {
                        const int r = row0 + ai * 128 + wr * 64 + m * 16 + fr;
                        const f32x4 s0 = *(const f32x4*)(SSQ + (size_t)r * 8), s1 = *(const f32x4*)(SSQ + (size_t)r * 8 + 4);
                        const float rr = rsqrtf((s0[0] + s0[1] + s0[2] + s0[3] + s1[0] + s1[1] + s1[2] + s1[3]) * (1.f / 256.f) + eps_());
                        float v[8];
#pragma unroll
                        for (int j = 0; j < 4; ++j) { v[j] = acc[ai][bj][m][0][j] * rr; v[4 + j] = acc[ai][bj][m][1][j] * rr; }
                        if (ropec && r >= NCTX) {
                            const int t = (r - NCTX) & 2047;
                            LAS const float* tb = rope + ((fq >> 1) ? (t & 63) : (t >> 6)) * 16;
                            const f32x4 c0 = *(LAS const f32x4*)tb, c1 = *(LAS const f32x4*)(tb + 4), sn0 = *(LAS const f32x4*)(tb + 8), sn1 = *(LAS const f32x4*)(tb + 12);
#pragma unroll
                            for (int j = 0; j < 8; ++j) {
                                const float pv = shx(v[j], 16);
                                const float c = j < 4 ? c0[j & 3] : c1[j & 3], sn = j < 4 ? sn0[j & 3] : sn1[j & 3];
                                v[j] = (fq & 1) ? v[j] * c + pv * sn : v[j] * c - pv * sn;
                            }
                        }
#pragma unroll
                        for (int j = 0; j < 8; ++j) v[j] *= SC_C;
                        EpiP1G::st8(QC + (size_t)r * 384 + c32 * 32 + fq * 8, v);
                        asm volatile("" ::: "memory");
                    }
            }
        }
    }
};
struct EpiKVG {
    static constexpr bool PERM = true, AFTER_DRAIN = false;
    bf16_t* dst0;
    DI void operator()(const pg8::f32x4 (&acc)[2][2][4][2], const pg8::Unit& u, int wr, int wc, int fr, int fq) const {
        asm volatile("" : "+v"(fr), "+v"(fq));
#pragma unroll
        for (int bj = 0; bj < 2; ++bj) {
            const int c32 = u.pn * 8 + bj * 4 + wc, head = c32 >> 2, part = c32 & 3;
            const int coff = head * 160 + (part < 2 ? part * 32 : 96 + (part - 2) * 32) + fq * 8;
#pragma unroll
            for (int ai = 0; ai < 2; ++ai)
#pragma unroll
                for (int m = 0; m < 4; ++m) {
                    const int rl = ai * 128 + wr * 64 + m * 16 + fr;
                    float v[8];
#pragma unroll
                    for (int j = 0; j < 4; ++j) { v[j] = acc[ai][bj][m][0][j]; v[4 + j] = acc[ai][bj][m][1][j]; }
                    EpiP1G::st8(dst0 + (size_t)rl * KCS + coff, v);
                }
        }
    }
};
struct PQUnit {
    int pm, pn;
    DI bool next(int i, pg8::Unit& u) const { if (i) return false; u.pm = pm; u.pn = pn; return true; }
    DI void a_ready(const pg8::Unit&) const {}
    DI void done(const pg8::Unit&) const {}
};
constexpr int NP1B_UNITS = 208;
DI void phaseP1(const Params& P, LAS unsigned char* lds, int layer, int phase_id) {
    unsigned* dep = (unsigned*)(P.ws + WS_CTL) + CW_DEP + 64 * phase_id;
    ((LAS f32x2*)(lds + EpiP1G::ROPE_LDS))[tidx()] = ((const f32x2*)(P.ws + WS_ROPE))[tidx()];
    __syncthreads();
    {
        pg8::Gemm g{(const bf16_t*)(P.ws + WS_H), (const bf16_t*)(P.ws + WS_WIN) + (size_t)layer * NPADW * 1024, NTOK, NPADW, 1024, 0};
        P1Order S{(int)gridDim.x, bidx(), dep};
        EpiP1G E{&P, layer, (LAS float*)(lds + 131072)};
        pg8::gemm_phase<EpiP1G, P1Order, true, true>(lds, g, S, E);
    }
    unsigned* qctr = (unsigned*)(P.ws + WS_CTL) + CW_QUEUE + 64 * phase_id;
    LAS volatile int* sitem = (LAS volatile int*)(lds + LDS_CTLOFF + 16);
    const bf16_t* U = (const bf16_t*)(P.ws + WS_U);
    for (;;) {
        if (tidx() == 0) *sitem = (int)atomicAdd(qctr, 1u);
        __syncthreads();
        const int c = *sitem;
        __syncthreads();
        if (c >= NP1B_UNITS) break;
        if (c < 96) {
            const int pm = c >> 1;
            dep_wait(dep + pm, 2u);
            pg8::Gemm g{U + (size_t)pm * 256 * USTR + U_CQ, (const bf16_t*)(P.ws + WS_WUQ) + (size_t)layer * 384 * 256, 256, 512, 256, USTR};
            OneUnit S{c & 1};
            EpiQG E{&P, pm * 256, (LAS const float*)(lds + EpiP1G::ROPE_LDS)};
            pg8::gemm_phase<EpiQG, OneUnit, true, false>(lds, g, S, E);
        } else {
            const bf16_t* A; bf16_t* dst; int lda;
            if (c < 192) {
                const int pm = (c - 96) >> 1;
                dep_wait(dep + pm, 2u);
                A = U + (size_t)pm * 256 * USTR + U_CKV; lda = USTR; dst = (bf16_t*)(P.ws + WS_KC) + (size_t)pm * 256 * KCS;
            } else {
                const int pq = (c - 192) >> 1, b = pq >> 1, half = pq & 1;
                A = (const bf16_t*)(P.ws + WS_CKVC) + ((size_t)(b * 4 + layer) * 512 + half * 256) * 128; lda = 128;
                dst = (bf16_t*)(P.ws + WS_KCC) + ((size_t)(layer * 4 + b) * 512 + half * 256) * KCS;
            }
            pg8::Gemm g{A, (const bf16_t*)(P.ws + WS_WUKV) + (size_t)layer * 512 * 128, 256, 512, 128, lda};
            OneUnit S{c & 1};
            EpiKVG E{dst};
            pg8::gemm_phase<EpiKVG, OneUnit, true, false>(lds, g, S, E);
        }
    }
}

struct EpiQ {
    bf16_t* QC; const float* SSQ; const float* rope;
    DI void operator()(int m, int c32, float* v) const {
        const f32x4 s0 = *(const f32x4*)(SSQ + (size_t)m * 8), s1 = *(const f32x4*)(SSQ + (size_t)m * 8 + 4);
        const float ss = s0[0] + s0[1] + s0[2] + s0[3] + s1[0] + s1[1] + s1[2] + s1[3];
        const float r = rsqrtf(ss * (1.f / 256.f) + eps_());
#pragma unroll
        for (int j = 0; j < 32; ++j) v[j] *= r;
        if ((c32 % 3) == 2 && m >= NCTX) rope32(v, rope, (m - NCTX) & 2047);
#pragma unroll
        for (int j = 0; j < 32; ++j) v[j] *= SC_C;
        store_bf16x32(QC + (size_t)m * 384 + c32 * 32, v);
    }
};
struct ARowKV {
    const bf16_t* U; const bf16_t* ckvc; int l;
    DI const bf16_t* row(int m) const {
        if (m < NTOK) return U + (size_t)m * USTR + U_CKV;
        const int mm = m - NTOK, b = mm >> 9, t = mm & 511;
        return ckvc + ((size_t)(b * 4 + l) * 512 + t) * 128;
    }
};
struct EpiKV {
    bf16_t* KC; bf16_t* KCC; int l;
    DI void operator()(int m, int c32, float* v) const {
        const int head = c32 >> 2, part = c32 & 3;
        bf16_t* dst;
        if (m < NTOK) dst = KC + (size_t)m * KCS;
        else { const int mm = m - NTOK, b = mm >> 9, t = mm & 511; dst = KCC + ((size_t)(l * 4 + b) * 512 + t) * KCS; }
        dst += head * 160 + (part < 2 ? part * 32 : 96 + (part - 2) * 32);
        store_bf16x32(dst, v);
    }
};
struct AttnDesc {
    const bf16_t* q; int qs;
    const bf16_t* k0; const bf16_t* v0; int ks0, vs0, nt0;
    const bf16_t* k1; const bf16_t* v1; int ks1, vs1;
    int nt;
    bf16_t* out; const bf16_t* sz;
    float lam, oml; const float* subg;
    const float* rpb; int qrow0, rs;
};

template <int MODE, bool FAST>
DI bool attn_unit(const AttnDesc& d, LAS unsigned char* lds, unsigned* qctr, unsigned* pend) {
    constexpr int DQK = (MODE == 1) ? 96 : 64;
    constexpr int NMAP = (MODE == 0) ? 2 : 1;
    constexpr int NKK = DQK / 16;
    constexpr int KSTR = DQK * 2 + 16;
    constexpr int NKC = DQK / 8;
    constexpr int NKL = (64 * NKC + NT - 1) / NT;
    constexpr int KBUF = 64 * KSTR;
    constexpr int VOFF = 2 * 64 * 208;
    constexpr int BOFF = VOFF + 16384;
    constexpr float THR = 6.f;
    const int tid = tidx(), lane = tid & 63, r32 = lane & 31, hh = lane >> 5;
    const int w = __builtin_amdgcn_readfirstlane(tid >> 6);

    const bool nawin = (MODE == 2) && (d.rpb != nullptr);
    auto tokmap = [&](int q) { return nawin ? ((2 * (w >> 2) + (q >> 4)) * 64 + (w & 3) * 16 + (q & 15)) : (w * 32 + q); };
    bf16x8 qf[NKK];
    {
        const bf16_t* qrow = d.q + (size_t)tokmap(r32) * d.qs + hh * 8;
#pragma unroll
        for (int kk = 0; kk < NKK; ++kk) qf[kk] = *(const bf16x8*)(qrow + kk * 16);
    }
    const bool has_bias = nawin;
    if (MODE == 2 && has_bias) {
        LAS float* bt = (LAS float*)(lds + BOFF);
        for (int idx = tid; idx < 15 * 31; idx += NT) bt[(idx / 31) * 32 + (idx % 31)] = d.rpb[idx] * LOG2E;
    }
    float m[NMAP], l[NMAP];
    f32x16 o[NMAP][2];
#pragma unroll
    for (int mp = 0; mp < NMAP; ++mp) {
        m[mp] = NEGBIG; l[mp] = 0.f;
#pragma unroll
        for (int i = 0; i < 16; ++i) { o[mp][0][i] = 0.f; o[mp][1][i] = 0.f; }
    }
    u32x4 kregA[NKL], vregA, kregB[NKL], vregB;
    auto load_tile = [&](int t, u32x4 (&kr)[NKL], u32x4& vr) {
        const bool s0 = t < d.nt0;
        const int tt = s0 ? t : t - d.nt0;
        const int ks = s0 ? d.ks0 : d.ks1, vs = s0 ? d.vs0 : d.vs1;
        const bf16_t* kb = (s0 ? d.k0 : d.k1) + (size_t)tt * 64 * ks;
        const bf16_t* vb = (s0 ? d.v0 : d.v1) + (size_t)tt * 64 * vs;
#pragma unroll
        for (int i = 0; i < NKL; ++i) { const int c = tid + NT * i, row = c / NKC, ch = c % NKC; if (c < 64 * NKC) kr[i] = *(const u32x4*)(kb + (size_t)row * ks + ch * 8); }
        { const int row = tid >> 3, ch = tid & 7; vr = *(const u32x4*)(vb + (size_t)row * vs + ch * 8); }
    };
    auto store_tile = [&](int buf, const u32x4 (&kr)[NKL], const u32x4& vr) {
        LAS unsigned char* kd = lds + buf * KBUF;
        LAS unsigned char* vd = lds + VOFF + buf * 8192;
#pragma unroll
        for (int i = 0; i < NKL; ++i) { const int c = tid + NT * i, row = c / NKC, ch = c % NKC; if (c < 64 * NKC) *(LAS u32x4*)(kd + row * KSTR + ch * 16) = kr[i]; }
        { const int row = tid >> 3, ch = tid & 7; *(LAS u32x4*)(vd + row * 128 + ((ch * 16) ^ (((row >> 1) & 1) << 6))) = vr; }
    };
    const int q4 = (lane & 15) >> 2, p4 = lane & 3, g16 = (lane >> 4) & 1, xs = (q4 >> 1) & 1;
    const int vlane = (4 * hh + q4) * 128 + g16 * 32 + p4 * 8;
    const int rqA = d.qrow0 + 2 * (w >> 2);
    const int rstA = min(max(rqA - 4, 0), 24), rstB = min(max(rqA - 3, 0), 24);
    const int cst = min(max((w & 3) * 16 - 8, 0), 32);

    auto tile_body = [&](int t, int cur) {
        {
            LAS const unsigned char* kb = lds + cur * KBUF;
            LAS const unsigned char* vb = lds + VOFF + cur * 8192;
            bf16x8 kf[2][NKK];
#pragma unroll
            for (int sub = 0; sub < 2; ++sub)
#pragma unroll
                for (int kk = 0; kk < NKK; ++kk) kf[sub][kk] = *(LAS const bf16x8*)(kb + (sub * 32 + r32) * KSTR + kk * 32 + hh * 16);
            bf16x8 vfr[2][2][2];
            auto vread = [&](int sub, int st, int dvb) {
                LAS const unsigned char* va = vb + vlane + (sub * 32 + st * 16) * 128 + ((dvb ^ xs) * 64);
                const s16x4 lo = __builtin_bit_cast(s16x4, __builtin_amdgcn_ds_read_tr16_b64_v4i16((LAS s16x4*)(va)));
                const s16x4 hi = __builtin_bit_cast(s16x4, __builtin_amdgcn_ds_read_tr16_b64_v4i16((LAS s16x4*)(va + 8 * 128)));
                const bf16x8 vf = {lo[0], lo[1], lo[2], lo[3], hi[0], hi[1], hi[2], hi[3]};
                return vf;
            };
#pragma unroll
            for (int st = 0; st < 2; ++st)
#pragma unroll
                for (int dvb = 0; dvb < 2; ++dvb) vfr[0][st][dvb] = vread(0, st, dvb);
            __builtin_amdgcn_sched_barrier(0);
            bf16x8 pf[NMAP][2][2];
#pragma unroll
            for (int mp = 0; mp < NMAP; ++mp) {
                f32x16 s[2];
#pragma unroll
                for (int sub = 0; sub < 2; ++sub) {
#pragma unroll
                    for (int i = 0; i < 16; ++i) s[sub][i] = 0.f;
#pragma unroll
                    for (int k2 = 0; k2 < NKK / NMAP; ++k2) {
                        const int kk = mp * (NKK / NMAP) + k2;
                        s[sub] = __builtin_amdgcn_mfma_f32_32x32x16_bf16(kf[sub][kk], qf[kk], s[sub], 0, 0, 0);
                    }
                }
                if constexpr (FAST) {
                    float ps0 = 0.f, ps1 = 0.f, ps2 = 0.f, ps3 = 0.f;
#pragma unroll
                    for (int sub = 0; sub < 2; ++sub)
#pragma unroll
                        for (int i = 0; i < 16; i += 4) {
                            const float p0 = __builtin_amdgcn_exp2f(s[sub][i]), p1 = __builtin_amdgcn_exp2f(s[sub][i + 1]);
                            const float p2 = __builtin_amdgcn_exp2f(s[sub][i + 2]), p3 = __builtin_amdgcn_exp2f(s[sub][i + 3]);
                            s[sub][i] = p0; s[sub][i + 1] = p1; s[sub][i + 2] = p2; s[sub][i + 3] = p3;
                            ps0 += p0; ps1 += p1; ps2 += p2; ps3 += p3;
                        }
                    l[mp] += (ps0 + ps1) + (ps2 + ps3);
                } else {
                float mx = s[0][0];
#pragma unroll
                for (int i = 1; i < 16; ++i) mx = fmaxf(mx, s[0][i]);
#pragma unroll
                for (int i = 0; i < 16; ++i) mx = fmaxf(mx, s[1][i]);
                mx = half_swap_max(mx);
                const float mnew = fmaxf(m[mp], mx);
                if (__any((mnew - m[mp]) > THR)) {
                    const float alpha = __builtin_amdgcn_exp2f(m[mp] - mnew);
#pragma unroll
                    for (int i = 0; i < 16; ++i) { o[mp][0][i] *= alpha; o[mp][1][i] *= alpha; }
                    l[mp] *= alpha;
                    m[mp] = mnew;
                }
                float ps = 0.f;
#pragma unroll
                for (int sub = 0; sub < 2; ++sub)
#pragma unroll
                    for (int i = 0; i < 16; ++i) { const float p = __builtin_amdgcn_exp2f(s[sub][i] - m[mp]); s[sub][i] = p; ps += p; }
                l[mp] += ps;
                }
#pragma unroll
                for (int sub = 0; sub < 2; ++sub)
#pragma unroll
                    for (int st = 0; st < 2; ++st) {
                        u32x4 pw = {pk2(s[sub][8 * st], s[sub][8 * st + 1]), pk2(s[sub][8 * st + 2], s[sub][8 * st + 3]),
                                    pk2(s[sub][8 * st + 4], s[sub][8 * st + 5]), pk2(s[sub][8 * st + 6], s[sub][8 * st + 7])};
                        pf[mp][sub][st] = __builtin_bit_cast(bf16x8, pw);
                    }
            }
#pragma unroll
            for (int st = 0; st < 2; ++st)
#pragma unroll
                for (int dvb = 0; dvb < 2; ++dvb) vfr[1][st][dvb] = vread(1, st, dvb);
#pragma unroll
            for (int sub = 0; sub < 2; ++sub)
#pragma unroll
                for (int st = 0; st < 2; ++st)
#pragma unroll
                    for (int dvb = 0; dvb < 2; ++dvb) {
#pragma unroll
                        for (int mp = 0; mp < NMAP; ++mp) o[mp][dvb] = __builtin_amdgcn_mfma_f32_32x32x16_bf16(vfr[sub][st][dvb], pf[mp][sub][st], o[mp][dvb], 0, 0, 0);
                    }
        }
    };
    auto local_body = [&](int t, int cur) {
        const int krow = d.rs + (t - d.nt0);
        if (krow >= rstA && krow < rstB + 8) {
            LAS const unsigned char* kb = lds + cur * KBUF;
            LAS const unsigned char* vb = lds + VOFF + cur * 8192;
            bf16x8 kf1[NKK];
#pragma unroll
            for (int kk = 0; kk < NKK; ++kk) kf1[kk] = *(LAS const bf16x8*)(kb + (cst + r32) * KSTR + kk * 32 + hh * 16);
            bf16x8 vf1[2][2];
#pragma unroll
            for (int st = 0; st < 2; ++st)
#pragma unroll
                for (int dvb = 0; dvb < 2; ++dvb) {
                    LAS const unsigned char* va = vb + vlane + (cst + st * 16) * 128 + ((dvb ^ xs) * 64);
                    const s16x4 lo = __builtin_bit_cast(s16x4, __builtin_amdgcn_ds_read_tr16_b64_v4i16((LAS s16x4*)(va)));
                    const s16x4 hi = __builtin_bit_cast(s16x4, __builtin_amdgcn_ds_read_tr16_b64_v4i16((LAS s16x4*)(va + 8 * 128)));
                    vf1[st][dvb] = (bf16x8){lo[0], lo[1], lo[2], lo[3], hi[0], hi[1], hi[2], hi[3]};
                }
            __builtin_amdgcn_sched_barrier(0);
            f32x16 s1;
#pragma unroll
            for (int i = 0; i < 16; ++i) s1[i] = 0.f;
#pragma unroll
            for (int kk = 0; kk < NKK; ++kk) s1 = __builtin_amdgcn_mfma_f32_32x32x16_bf16(kf1[kk], qf[kk], s1, 0, 0, 0);
            {
                const int rql = rqA + (r32 >> 4), qcl = (w & 3) * 16 + (r32 & 15);
                const int rstl = min(max(rql - 4, 0), 24), wstl = min(max(qcl - 8, 0), 48);
                const bool rowok = (krow >= rstl) && (krow < rstl + 8);
                int kofs = rowok ? (cst + 4 * hh - wstl) : 4096;
                int bidx = (rowok ? (krow - rql + 7) : 0) * 32 + cst + 4 * hh - qcl + 15;
                asm volatile("" : "+v"(kofs), "+v"(bidx));
                LAS const float* bt = (LAS const float*)(lds + BOFF) + bidx;
#pragma unroll
                for (int i = 0; i < 16; ++i) {
                    const int kci = (i & 3) + 8 * (i >> 2);
                    const bool inw = (unsigned)(kci + kofs) < 16u;
                    s1[i] = inw ? s1[i] + bt[kci] : NEGBIG;
                }
            }
            if constexpr (FAST) {
                float ps0 = 0.f, ps1 = 0.f, ps2 = 0.f, ps3 = 0.f;
#pragma unroll
                for (int i = 0; i < 16; i += 4) {
                    const float p0 = __builtin_amdgcn_exp2f(s1[i]), p1 = __builtin_amdgcn_exp2f(s1[i + 1]);
                    const float p2 = __builtin_amdgcn_exp2f(s1[i + 2]), p3 = __builtin_amdgcn_exp2f(s1[i + 3]);
                    s1[i] = p0; s1[i + 1] = p1; s1[i + 2] = p2; s1[i + 3] = p3;
                    ps0 += p0; ps1 += p1; ps2 += p2; ps3 += p3;
                }
                l[0] += (ps0 + ps1) + (ps2 + ps3);
            } else {
                float mx = s1[0];
#pragma unroll
                for (int i = 1; i < 16; ++i) mx = fmaxf(mx, s1[i]);
                mx = half_swap_max(mx);
                const float mnew = fmaxf(m[0], mx);
                if (__any((mnew - m[0]) > THR)) {
                    const float alpha = __builtin_amdgcn_exp2f(m[0] - mnew);
#pragma unroll
                    for (int i = 0; i < 16; ++i) { o[0][0][i] *= alpha; o[0][1][i] *= alpha; }
                    l[0] *= alpha;
                    m[0] = mnew;
                }
                float ps = 0.f;
#pragma unroll
                for (int i = 0; i < 16; ++i) { const float p = __builtin_amdgcn_exp2f(s1[i] - m[0]); s1[i] = p; ps += p; }
                l[0] += ps;
            }
#pragma unroll
            for (int st = 0; st < 2; ++st) {
                u32x4 pw = {pk2(s1[8 * st], s1[8 * st + 1]), pk2(s1[8 * st + 2], s1[8 * st + 3]), pk2(s1[8 * st + 4], s1[8 * st + 5]), pk2(s1[8 * st + 6], s1[8 * st + 7])};
                const bf16x8 pfr = __builtin_bit_cast(bf16x8, pw);
#pragma unroll
                for (int dvb = 0; dvb < 2; ++dvb) o[0][dvb] = __builtin_amdgcn_mfma_f32_32x32x16_bf16(vf1[st][dvb], pfr, o[0][dvb], 0, 0, 0);
            }
        }
    };
    auto tile_any = [&](int t, int cur) { if (MODE == 2 && nawin && t >= d.nt0) local_body(t, cur); else tile_body(t, cur); };
    load_tile(0, kregA, vregA);
    if (d.nt > 1) load_tile(1, kregB, vregB);
    store_tile(0, kregA, vregA);
    __syncthreads();
    if (pend != nullptr && tid == 0) (void)__hip_atomic_fetch_add(pend, 1u, __ATOMIC_RELAXED, __HIP_MEMORY_SCOPE_AGENT);
    for (int t = 0; t < d.nt; t += 2) {
        if (t + 2 < d.nt) load_tile(t + 2, kregA, vregA);
        tile_any(t, 0);
        if (t + 1 < d.nt) store_tile(1, kregB, vregB);
        __syncthreads();
        if (t + 1 < d.nt) {
            if (t + 3 < d.nt) load_tile(t + 3, kregB, vregB);
            tile_any(t + 1, 1);
            if (t + 2 < d.nt) store_tile(0, kregA, vregA);
            __syncthreads();
        }
    }
    int nxt_item = 0;
    if (qctr != nullptr && tid == 0) nxt_item = (int)atomicAdd(qctr, 1u);
    u32x4 zv4[4];
#pragma unroll
    for (int i = 0; i < 4; ++i) { const int idx = lane + 64 * i, row = idx >> 3, ch = idx & 7; zv4[i] = *(const u32x4*)(d.sz + (size_t)tokmap(row) * USTR + ch * 8); }
    float y[2][16];
    {
        float inv[NMAP];
#pragma unroll
        for (int mp = 0; mp < NMAP; ++mp) {
            const float lt = half_swap_sum(l[mp]);
            if (FAST) { if (__any(!(lt > 1e-30f && lt < 1e30f)) && lane == 0) *(LAS volatile unsigned*)(lds + LDS_CTLOFF + 32) = 1u; }
            inv[mp] = 1.f / lt;
        }
        if (MODE == 0) {
            float ss = 0.f;
#pragma unroll
            for (int dvb = 0; dvb < 2; ++dvb)
#pragma unroll
                for (int i = 0; i < 16; ++i) { const float v = o[0][dvb][i] * inv[0] - d.lam * (o[NMAP - 1][dvb][i] * inv[NMAP - 1]); y[dvb][i] = v; ss += v * v; }
            ss = half_swap_sum(ss);
            const float r = rsqrtf(ss * (1.f / 64.f) + eps_()) * d.oml;
#pragma unroll
            for (int dvb = 0; dvb < 2; ++dvb)
#pragma unroll
                for (int i = 0; i < 16; ++i) y[dvb][i] *= r * d.subg[dvb * 32 + crow(i, hh)];
        } else {
#pragma unroll
            for (int dvb = 0; dvb < 2; ++dvb)
#pragma unroll
                for (int i = 0; i < 16; ++i) y[dvb][i] = o[0][dvb][i] * inv[0];
        }
    }
    LAS bf16_t* stg = (LAS bf16_t*)(lds + w * 32 * 144);
#pragma unroll
    for (int dvb = 0; dvb < 2; ++dvb)
#pragma unroll
        for (int i = 0; i < 16; ++i) stg[r32 * 72 + dvb * 32 + crow(i, hh)] = (bf16_t)(pk2(y[dvb][i], 0.f) & 0xffffu);
    __builtin_amdgcn_s_waitcnt(0xc07f);
#pragma unroll
    for (int i = 0; i < 4; ++i) {
        const int idx = lane + 64 * i, row = idx >> 3, ch = idx & 7;
        const u32x4 ov = *(LAS const u32x4*)((LAS const unsigned char*)stg + row * 144 + ch * 16);
        const u32x4 zv = zv4[i];
        u32x4 rv;
#pragma unroll
        for (int j = 0; j < 4; ++j) {
            const float a0 = bf2f(ov[j] & 0xffffu) * bf2f(zv[j] & 0xffffu), a1 = bf2f(ov[j] >> 16) * bf2f(zv[j] >> 16);
            rv[j] = pk2(a0, a1);
        }
        asm volatile("global_store_dwordx4 %0, %1, off sc1\n\ts_nop 1" :: "v"(d.out + (size_t)tokmap(row) * DM + ch * 8), "v"(rv) : "memory");
    }
    if (qctr != nullptr && tid == 0) *(LAS volatile int*)(lds + LDS_CTLOFF + 16) = nxt_item;
    __syncthreads();
    if (FAST) return *(LAS volatile unsigned*)(lds + LDS_CTLOFF + 32) == 0u;
    return true;
}

DI void conv_item(const Params& P, int layer, int tile) {
    const bf16_t* U = (const bf16_t*)(P.ws + WS_U);
    bf16_t* YG = (bf16_t*)(P.ws + WS_YG);
    const float* cw = P.in[16] + layer * 3 * 256;
    const int tid = tidx(), ch = tid & 31, gA = tile * 256 + (tid >> 5) * 16;
    float w[3][8];
#pragma unroll
    for (int dd = 0; dd < 3; ++dd) {
        const f32x4 w0 = *(const f32x4*)(cw + dd * 256 + ch * 8), w1 = *(const f32x4*)(cw + dd * 256 + ch * 8 + 4);
#pragma unroll
        for (int j = 0; j < 4; ++j) { w[dd][j] = w0[j]; w[dd][4 + j] = w1[j]; }
    }
    const int L = (gA < NCTX) ? 256 : 2048;
    const int tposA = (gA < NCTX) ? (gA & 255) : ((gA - NCTX) & 2047);
    const bf16_t* ur = U + (size_t)gA * USTR + ch * 8;
    auto prod = [&](u32x4 bc, u32x4 bh, bool ok, float* pr) {
#pragma unroll
        for (int j = 0; j < 4; ++j) {
            pr[2 * j] = ok ? bf2f(bc[j] & 0xffffu) * bf2f(bh[j] & 0xffffu) : 0.f;
            pr[2 * j + 1] = ok ? bf2f(bc[j] >> 16) * bf2f(bh[j] >> 16) : 0.f;
        }
    };
    float pm[8], pc[8];
    {
        const bf16_t* r0 = ur - USTR;
        const u32x4 bcm = *(const u32x4*)(r0 + U_BC), bhm = *(const u32x4*)(r0 + U_BH), bc0 = *(const u32x4*)(ur + U_BC), bh0 = *(const u32x4*)(ur + U_BH);
        prod(bcm, bhm, tposA > 0, pm);
        prod(bc0, bh0, true, pc);
    }
#pragma unroll
    for (int bt = 0; bt < 2; ++bt) {
        u32x4 BC[8], BH[8], BB[8], ZZ[8];
#pragma unroll
        for (int q = 0; q < 8; ++q) {
            const bf16_t* rq = ur + (size_t)(bt * 8 + q) * USTR;
            BB[q] = *(const u32x4*)(rq + U_BB); ZZ[q] = *(const u32x4*)(rq + U_BZ);
            BC[q] = *(const u32x4*)(rq + USTR + U_BC); BH[q] = *(const u32x4*)(rq + USTR + U_BH);
        }
#pragma unroll
        for (int q = 0; q < 8; ++q) {
            const int i = bt * 8 + q;
            float pn[8];
            prod(BC[q], BH[q], tposA + i + 1 < L, pn);
            u32x4 rv;
#pragma unroll
            for (int j = 0; j < 4; ++j) {
                const float a0 = (pm[2 * j] * w[0][2 * j] + pc[2 * j] * w[1][2 * j] + pn[2 * j] * w[2][2 * j]) * bf2f(BB[q][j] & 0xffffu) * bf2f(ZZ[q][j] & 0xffffu);
                const float a1 = (pm[2 * j + 1] * w[0][2 * j + 1] + pc[2 * j + 1] * w[1][2 * j + 1] + pn[2 * j + 1] * w[2][2 * j + 1]) * bf2f(BB[q][j] >> 16) * bf2f(ZZ[q][j] >> 16);
                rv[j] = pk2(a0, a1);
            }
            asm volatile("global_store_dwordx4 %0, %1, off sc1\n\ts_nop 1" :: "v"(YG + (size_t)(gA + i) * DM + 256 + ch * 8), "v"(rv) : "memory");
#pragma unroll
            for (int j = 0; j < 8; ++j) { pm[j] = pc[j]; pc[j] = pn[j]; }
        }
    }
}

constexpr int P2_ATT = 384 + 192 + 48, P2_OUT = 192, P2_ITEMS = P2_ATT + P2_OUT;
DI int rstart(int r) { return min(max(r - 4, 0), 24); }

DI int phaseP2(const Params& P, LAS unsigned char* lds, int layer, int phase_id) {
    const bf16_t* U = (const bf16_t*)(P.ws + WS_U);
    const bf16_t* KC = (const bf16_t*)(P.ws + WS_KC);
    const bf16_t* KCC = (const bf16_t*)(P.ws + WS_KCC);
    const bf16_t* QC = (const bf16_t*)(P.ws + WS_QC);
    bf16_t* YG = (bf16_t*)(P.ws + WS_YG);
    unsigned* ctr = (unsigned*)(P.ws + WS_CTL) + CW_QUEUE + 64 * phase_id;
    LAS volatile int* sitem = (LAS volatile int*)(lds + LDS_CTLOFF + 16);
    const float* lamp = (const float*)(P.ws + WS_LAM) + layer * 2;
    unsigned* dep = (unsigned*)(P.ws + WS_CTL) + CW_DEP + 64 * (phase_id & 31);
    int first_tail = 0;
    unsigned* pend = nullptr;
    if (tidx() == 0) *sitem = (int)atomicAdd(ctr, 1u);
    for (;;) {
        __syncthreads();
        const int item = *sitem;
        __syncthreads();
        if (tidx() == 0) *(LAS volatile unsigned*)(lds + LDS_CTLOFF + 32) = 0u;
        if (item >= 576 && pend != nullptr) { dep_signal(pend); pend = nullptr; }
        if (item >= P2_ATT) { first_tail = item; break; }
        AttnDesc d;
        d.k1 = nullptr; d.v1 = nullptr; d.ks1 = 0; d.vs1 = 0; d.rpb = nullptr; d.qrow0 = 0; d.rs = 0; d.lam = 0.f; d.oml = 0.f; d.subg = nullptr;
        if (item >= 576) {
            int nx = 0;
            if (tidx() == 0) nx = (int)atomicAdd(ctr, 1u);
            conv_item(P, layer, item - 576);
            dep_signal(dep + (item - 576));
            if (tidx() == 0) *sitem = nx;
            continue;
        }
        int kind, panel;
        if (item < 384) {
            const int j = item & 127, b = j >> 5, h = (j >> 3) & 3, qb = j & 7;
            kind = item >> 7; panel = 16 + b * 8 + qb;
            const size_t tokb = NCTX + (size_t)b * 2048, tok0 = tokb + qb * 256;
            const size_t crow0 = (size_t)(b * 4 + layer) * 512;
            d.nt0 = 8; d.nt = 40;
            if (kind == 0) {
                d.q = U + tok0 * USTR + U_AQ + h * 64; d.qs = USTR;
                d.k0 = (const bf16_t*)(P.ws + WS_CAK) + crow0 * 256 + h * 64; d.v0 = (const bf16_t*)(P.ws + WS_CAV) + crow0 * 256 + h * 64; d.ks0 = 256; d.vs0 = 256;
                d.k1 = U + tokb * USTR + U_AK + h * 64; d.v1 = U + tokb * USTR + U_AV + h * 64; d.ks1 = USTR; d.vs1 = USTR;
                d.out = YG + tok0 * DM + h * 64; d.sz = U + tok0 * USTR + U_AZ + h * 64;
            } else if (kind == 1) {
                d.q = QC + tok0 * 384 + h * 96; d.qs = 384;
                d.k0 = KCC + ((size_t)(layer * 4 + b) * 512) * KCS + h * 160; d.v0 = d.k0 + 96; d.ks0 = KCS; d.vs0 = KCS;
                d.k1 = KC + tokb * KCS + h * 160; d.v1 = d.k1 + 96; d.ks1 = KCS; d.vs1 = KCS;
                d.out = YG + tok0 * DM + 512 + h * 64; d.sz = U + tok0 * USTR + U_CZ + h * 64;
            } else {
                const int r = 4 * qb, rs = rstart(r), nloc = rstart(r + 3) + 8 - rs;
                d.q = U + tok0 * USTR + U_DQ + h * 64; d.qs = USTR;
                d.k0 = (const bf16_t*)(P.ws + WS_CDK) + crow0 * 256 + h * 64; d.v0 = (const bf16_t*)(P.ws + WS_CDV) + crow0 * 256 + h * 64; d.ks0 = 256; d.vs0 = 256;
                d.k1 = U + (tokb + rs * 64) * USTR + U_DK + h * 64; d.v1 = U + (tokb + rs * 64) * USTR + U_DV + h * 64; d.ks1 = USTR; d.vs1 = USTR; d.nt = 8 + nloc;
                d.out = YG + tok0 * DM + 768 + h * 64; d.sz = U + tok0 * USTR + U_DZ + h * 64;
                d.rpb = P.in[21] + (size_t)(layer * 4 + h) * 15 * 31; d.qrow0 = r; d.rs = rs;
            }
        } else {
            const int jj = item - 384, j = jj & 63, b = j >> 2, h = j & 3;
            kind = jj >> 6; panel = b;
            const size_t tokb = (size_t)b * 256, tok0 = tokb;
            d.nt0 = 4; d.nt = 4;
            if (kind == 0) {
                d.q = U + tok0 * USTR + U_AQ + h * 64; d.qs = USTR;
                d.k0 = U + tokb * USTR + U_AK + h * 64; d.v0 = U + tokb * USTR + U_AV + h * 64; d.ks0 = USTR; d.vs0 = USTR;
                d.out = YG + tok0 * DM + h * 64; d.sz = U + tok0 * USTR + U_AZ + h * 64;
            } else if (kind == 1) {
                d.q = QC + tok0 * 384 + h * 96; d.qs = 384;
                d.k0 = KC + tokb * KCS + h * 160; d.v0 = d.k0 + 96; d.ks0 = KCS; d.vs0 = KCS;
                d.out = YG + tok0 * DM + 512 + h * 64; d.sz = U + tok0 * USTR + U_CZ + h * 64;
            } else {
                d.q = U + tok0 * USTR + U_DQ + h * 64; d.qs = USTR;
                d.k0 = U + tokb * USTR + U_DK + h * 64; d.v0 = U + tokb * USTR + U_DV + h * 64; d.ks0 = USTR; d.vs0 = USTR;
                d.out = YG + tok0 * DM + 768 + h * 64; d.sz = U + tok0 * USTR + U_DZ + h * 64;
            }
        }
        if (kind == 0) {
            d.lam = lamp[0]; d.oml = 1.f - lamp[1]; d.subg = P.in[15] + layer * 64;
            if (!attn_unit<0, true>(d, lds, ctr, pend)) attn_unit<0, false>(d, lds, nullptr, nullptr);
        } else if (kind == 1) { if (!attn_unit<1, true>(d, lds, ctr, pend)) attn_unit<1, false>(d, lds, nullptr, nullptr); }
        else { if (!attn_unit<2, true>(d, lds, ctr, pend)) attn_unit<2, false>(d, lds, nullptr, nullptr); }
        pend = dep + panel;
    }
    return first_tail;
}

DI void phaseP2_tail(LAS unsigned char* lds, int layer, int phase_id, int item) {
#ifdef __HIP_DEVICE_COMPILE__
    typedef __attribute__((address_space(4))) const Params* KArgPtr;
    KArgPtr pp_ = (KArgPtr)__builtin_amdgcn_kernarg_segment_ptr();
    asm volatile("" : "+s"(pp_));
    Params P;
    __builtin_memcpy(&P, pp_, sizeof(Params));
#else
    Params P{};
#endif
    unsigned* ctr = (unsigned*)(P.ws + WS_CTL) + CW_QUEUE + 64 * phase_id;
    unsigned* dep = (unsigned*)(P.ws + WS_CTL) + CW_DEP + 64 * (phase_id & 31);
    LAS volatile int* sitem = (LAS volatile int*)(lds + LDS_CTLOFF + 16);
    const int nitems = P2_ITEMS + (layer + 1 < DEPTH ? LP_TOTAL : 0);
    for (;;) {
        if (item >= nitems) break;
        if (item >= P2_ITEMS) {
            int nx = 0;
            if (tidx() == 0) nx = (int)atomicAdd(ctr, 1u);
            layer_prep_item(P, lds, layer + 1, item - P2_ITEMS);
            __syncthreads();
            if (tidx() == 0) *sitem = nx;
        } else {
            const int idx = item - P2_ATT, pmi = idx >> 2, pm = pmi < 32 ? 16 + pmi : pmi - 32;
            dep_wait(dep + pm, 13u);
            pg8::Gemm g{(const bf16_t*)(P.ws + WS_YG), (const bf16_t*)(P.ws + WS_WOUT) + (size_t)layer * 1024 * 1024, NTOK, 1024, 1024, 0};
            PQUnit S{pm, idx & 3};
            EpiP3G E{&P, layer};
            pg8::gemm_phase<EpiP3G, PQUnit, true, true>(lds, g, S, E);
            if (tidx() == 0) *sitem = (int)atomicAdd(ctr, 1u);
        }
        __syncthreads();
        item = *sitem;
        __syncthreads();
    }
}

DI void phaseP3(const Params& P, LAS unsigned char* lds, int layer, int phase_id) {
    pg8::Gemm g{(const bf16_t*)(P.ws + WS_YG), (const bf16_t*)(P.ws + WS_WOUT) + (size_t)layer * 1024 * 1024, NTOK, 1024, 1024, 0};
    pg8::StaticOrder S; S.init(NTOK, 1024, (int)gridDim.x, bidx());
    EpiP3G E{&P, layer};
    pg8::gemm_phase<EpiP3G, pg8::StaticOrder, true, true>(lds, g, S, E);
    pg8::Unit u;
    if (!S.next(0, u) && layer + 1 < DEPTH) {
        const int nidle = (int)gridDim.x - 192;
        for (int it = bidx() - 192; it < LP_TOTAL; it += nidle) layer_prep_item(P, lds, layer + 1, it);
    }
    if (FUSE_N && S.next(0, u)) {
        unsigned* cnt = (unsigned*)(P.ws + WS_CTL) + CW_DEP + 64 * phase_id + u.pm;
        dep_signal(cnt);
        dep_wait(cnt, 4u);
        const int r0 = u.pm * 256 + u.pn * 64;
        if (layer + 1 < DEPTH) phaseN_rows(P, layer + 1, r0, r0 + 64, 32);
        else phaseFinal_rows(P, r0, r0 + 64, 32);
    }
}

#define XB_TMO      128
#define XB_XCNT(j)  (256  + 64 * (j))
#define XB_XSUB(j)  (1280 + 64 * (j))
#define XB_XGEN(j)  (2304 + 64 * (j))
#define XB_TOP      3328
#define XB_TOPGEN   3392
#define XCD_BAR_WORDS 3456
#define XB_SPIN_CAP (1u << 18)
DI unsigned xb_ld(unsigned* p) { return __hip_atomic_load(p, __ATOMIC_RELAXED, __HIP_MEMORY_SCOPE_AGENT); }
DI unsigned xb_add(unsigned* p, unsigned v) { return __hip_atomic_fetch_add(p, v, __ATOMIC_RELAXED, __HIP_MEMORY_SCOPE_AGENT); }
DI unsigned xb_xcc_id() { return (unsigned)__builtin_amdgcn_s_getreg((3 << 11) | 20) & 0xFu; }
#define XB_SPIN(cond, bar) do { unsigned _sp = 0; while (cond) { __builtin_amdgcn_s_sleep(1); \
    if ((++_sp & 255u) == 0u) { if (xb_ld(&(bar)[XB_TMO])) break; if (_sp > XB_SPIN_CAP) { atomicAdd(&(bar)[XB_TMO], 1u); break; } } } } while (0)
struct XcdBarrier { unsigned* bar; unsigned x; volatile LAS unsigned* st; };
DI XcdBarrier xcd_barrier_post(unsigned* bar, volatile LAS unsigned* st) {
    XcdBarrier b; b.bar = bar; b.x = xb_xcc_id(); b.st = st;
    if (tidx() == 0) (void)xb_add(&bar[XB_XCNT(b.x)], 1u);
    return b;
}
DI void xcd_barrier_complete(unsigned* bar, unsigned x, unsigned& nloc, unsigned& nx) {
    const unsigned G = gridDim.x * gridDim.y * gridDim.z;
    unsigned sum, cnt, mine, sp = 0u;
    for (;;) {
        sum = 0u; cnt = 0u; mine = 0u;
#pragma unroll
        for (unsigned j = 0; j < 16; ++j) { const unsigned c = xb_ld(&bar[XB_XCNT(j)]); sum += c; cnt += (c > 0u) ? 1u : 0u; }
        if (sum == G) { mine = xb_ld(&bar[XB_XCNT(x)]); break; }
        __builtin_amdgcn_s_sleep(1);
        if ((++sp & 255u) == 0u) { if (xb_ld(&bar[XB_TMO])) break; if (sp > XB_SPIN_CAP) { atomicAdd(&bar[XB_TMO], 1u); break; } }
    }
    nloc = mine > 0u ? mine : 1u; nx = cnt > 0u ? cnt : 1u;
}
DI void xcd_barrier(const XcdBarrier& b) {
    asm volatile("s_waitcnt vmcnt(0)" ::: "memory");
    __syncthreads();
    if (tidx() == 0) {
        unsigned* bar = b.bar;
        __builtin_amdgcn_s_waitcnt(0);
        unsigned nloc = b.st[0], nx = b.st[1];
        if (nloc == 0u) { xcd_barrier_complete(bar, b.x, nloc, nx); b.st[0] = nloc; b.st[1] = nx; }
        const unsigned old = xb_add(&bar[XB_XSUB(b.x)], 1u);
        const unsigned gen = old / nloc;
        if (old + 1u == (gen + 1u) * nloc) {
            __builtin_amdgcn_fence(__ATOMIC_RELEASE, "agent");
            asm volatile("s_waitcnt vmcnt(0)" ::: "memory");
            const unsigned og = xb_add(&bar[XB_TOP], 1u);
            const unsigned tg = og / nx;
            if (og + 1u == (tg + 1u) * nx) xb_add(&bar[XB_TOPGEN], 1u);
            else XB_SPIN(xb_ld(&bar[XB_TOPGEN]) == tg, bar);
            __builtin_amdgcn_fence(__ATOMIC_ACQUIRE, "agent");
            xb_add(&bar[XB_XGEN(b.x)], 1u);
            asm volatile("s_waitcnt vmcnt(0)" ::: "memory");
        } else {
            XB_SPIN(xb_ld(&bar[XB_XGEN(b.x)]) == gen, bar);
            __builtin_amdgcn_fence(__ATOMIC_ACQUIRE, "agent");
            asm volatile("s_waitcnt vmcnt(0)" ::: "memory");
        }
    }
    __syncthreads();
}
constexpr int CW_BAR = 8192;

__global__ void __launch_bounds__(NT, 2) hybrid_fwd(Params P0_) {
    extern __shared__ __attribute__((aligned(16))) unsigned char smem[];
    LAS unsigned char* lds = (LAS unsigned char*)smem;
#if MEGA
    volatile LAS unsigned* xst = (volatile LAS unsigned*)(lds + LDS_CTLOFF);
    if (tidx() == 0) { xst[0] = 0u; xst[1] = 0u; }
    __syncthreads();
    const XcdBarrier xbar = xcd_barrier_post((unsigned*)(P0_.ws + WS_CTL) + CW_BAR, xst);
#endif
    for (int phc = P0_.ph_lo; phc < P0_.ph_hi; ++phc) {
        int ph = phc;
        asm volatile("" : "+s"(ph));
#ifdef __HIP_DEVICE_COMPILE__
        typedef __attribute__((address_space(4))) const Params* KArgPtr;
        KArgPtr pp_ = (KArgPtr)__builtin_amdgcn_kernarg_segment_ptr();
        asm volatile("" : "+s"(pp_));
        Params P;
        __builtin_memcpy(&P, pp_, sizeof(Params));
#else
        const Params P = P0_;
#endif
#ifdef REPEAT
        for (int rep = 0; rep < 2; ++rep) {
#else
        const int rep = 0;
        {
#endif
            bool again = false;
            if (ph == 0) {
                phase0(P, lds);
                dep_wait((unsigned*)(P.ws + WS_CTL) + CW_DEP, 48u);
                phaseN(P, 0);
            }
            else if (ph == 1) { }
            else {
                const int layer = (ph - 2) / 3, sub = (ph - 2) % 3;
                if (sub == 0) { phaseP1(P, lds, layer, ph); }
                else if (sub == 1) { const int ft = phaseP2(P, lds, layer, ph + 32 * rep); phaseP2_tail(lds, layer, ph + 32 * rep, ft); again = (REPEAT_MASK & 16) != 0; }
                else {
                    if (layer + 1 < DEPTH) phaseN(P, layer + 1); else phaseFinal_rows(P, bidx() * 32, NTOK, gridDim.x * 32);
                }
            }
#ifdef REPEAT
            if (!again || rep == 1) break;
            xcd_barrier(xbar);
#endif
        }
#if MEGA
        if (ph + 1 < P0_.ph_hi && ph != 1) xcd_barrier(xbar);
#ifdef DOUBLE_BAR
        if (ph + 1 < P0_.ph_hi) xcd_barrier(xbar);
#endif
#endif
    }
}

extern "C" void kernel_launch(void* const* d_in, const int* in_sizes, int n_in, void* d_out, int out_size, void* d_ws, size_t ws_size, hipStream_t stream) {
    static int grid_blocks = 0;
    if (grid_blocks == 0) {
        if (n_in != 24 || ws_size < WS_END) { fprintf(stderr, "kernel_launch: unexpected inputs (n_in %d, ws %zu)\n", n_in, ws_size); grid_blocks = -1; return; }
        int dev = 0, cus = 0, per_cu = 0;
        hipGetDevice(&dev);
        hipDeviceGetAttribute(&cus, hipDeviceAttributeMultiprocessorCount, dev);
        hipFuncSetAttribute((const void*)hybrid_fwd, hipFuncAttributeMaxDynamicSharedMemorySize, LDS_BYTES);
        hipOccupancyMaxActiveBlocksPerMultiprocessor(&per_cu, (const void*)hybrid_fwd, NT, LDS_BYTES);
        if (per_cu < 1) { fprintf(stderr, "kernel_launch: occupancy query says %d blocks per CU\n", per_cu); per_cu = 1; }
        if (per_cu > 1) per_cu = 1;
        grid_blocks = cus * per_cu;
        (void)hipGetLastError();
    }
    if (grid_blocks < 0) return;
    hipMemsetAsync((char*)d_ws + WS_CTL, 0, 65536, stream);
    Params p{};
    for (int i = 0; i < 24; ++i) p.in[i] = (const float*)d_in[i];
    p.out = (float*)d_out;
    p.ws = (unsigned char*)d_ws;
#if MEGA
    p.ph_lo = 0; p.ph_hi = NPHASE;
    void* args[] = {&p};
    hipError_t e = hipLaunchCooperativeKernel((const void*)hybrid_fwd, dim3(grid_blocks), dim3(NT), args, LDS_BYTES, stream);
    if (e != hipSuccess) fprintf(stderr, "cooperative launch failed: %s (grid %d)\n", hipGetErrorString(e), grid_blocks);
#else
    for (int ph = 0; ph < NPHASE; ++ph) {
        p.ph_lo = ph; p.ph_hi = ph + 1;
        hipLaunchKernelGGL(hybrid_fwd, dim3(grid_blocks), dim3(NT), LDS_BYTES, stream, p);
    }
#endif
}
```

```cpp
#include <hip/hip_runtime.h>
#include <hip/hip_cooperative_groups.h>
#include <stdint.h>
#include <stdio.h>
namespace cg = cooperative_groups;

#ifndef MEGA
#define MEGA 1
#endif
#ifndef FUSE_N
#define FUSE_N 0
#endif
#ifndef REPEAT_MASK
#define REPEAT_MASK 0
#endif

#define DI __device__ __forceinline__
#define LAS __attribute__((address_space(3)))
#define GAS __attribute__((address_space(1)))
typedef unsigned short bf16_t;
typedef short bf16x8 __attribute__((ext_vector_type(8)));
typedef short s16x4 __attribute__((ext_vector_type(4)));
typedef float f32x16 __attribute__((ext_vector_type(16)));
typedef float f32x4 __attribute__((ext_vector_type(4)));
typedef float f32x2 __attribute__((ext_vector_type(2)));
typedef unsigned u32x4 __attribute__((ext_vector_type(4)));
typedef unsigned u32x2 __attribute__((ext_vector_type(2)));
typedef __bf16 bf16v2 __attribute__((ext_vector_type(2)));

constexpr int DM = 1024, NCTX = 4096, NLAT = 8192, NTOK = 12288, DEPTH = 4;
constexpr int USTR = 3744;
constexpr int NPADW = 3840;
constexpr int U_AQ = 0, U_AK = 256, U_AV = 512, U_AZ = 768, U_BB = 1024, U_BC = 1280, U_BH = 1536, U_BZ = 1792,
              U_CQ = 2048, U_CKV = 2304, U_CZ = 2432, U_DQ = 2688, U_DK = 2944, U_DV = 3200, U_DZ = 3456, U_KPE = 3712;
constexpr int KCS = 640;
constexpr float LOG2E = 1.4426950408889634f, EPS = 1e-6f;
constexpr float SC_A = 0.17677669529663687f * LOG2E;
constexpr float SC_C = 0.10206207261596575f * LOG2E;
constexpr float SC_D = 0.125f * LOG2E;
constexpr float NEGBIG = -1e30f;

constexpr size_t O_YP = 0, O_YS = 4194304, O_SAK = 12582912, O_SAV = 16777216, O_SCKV = 20971520, O_SKPE = 23068672,
                 O_SDK = 23592960, O_SDV = 27787264;

constexpr size_t WS_CTL = 0;
constexpr size_t WS_MOD = 65536;
constexpr size_t WS_ROPE = WS_MOD + 4 * 5 * 3072 * 4;
constexpr size_t WS_LAM = WS_ROPE + 64 * 16 * 4;
constexpr size_t WS_SSQ = WS_LAM + 256;
constexpr size_t WS_WIN = WS_SSQ + (size_t)NTOK * 8 * 4;
constexpr size_t WS_WOUT = WS_WIN + (size_t)4 * NPADW * 1024 * 2;
constexpr size_t WS_WUQ = WS_WOUT + (size_t)4 * 1024 * 1024 * 2;
constexpr size_t WS_WUKV = WS_WUQ + (size_t)4 * 384 * 256 * 2;
constexpr size_t WS_CAK = WS_WUKV + (size_t)4 * 512 * 128 * 2;
constexpr size_t WS_CAV = WS_CAK + 4194304;
constexpr size_t WS_CDK = WS_CAV + 4194304;
constexpr size_t WS_CDV = WS_CDK + 4194304;
constexpr size_t WS_CKVC = WS_CDV + 4194304;
constexpr size_t WS_KCC = WS_CKVC + 2097152;
constexpr size_t WS_H = WS_KCC + (size_t)4 * 4 * 512 * KCS * 2;
constexpr size_t WS_U = WS_H + (size_t)NTOK * 1024 * 2;
constexpr size_t WS_KC = WS_U + (size_t)NTOK * USTR * 2;
constexpr size_t WS_QC = WS_KC + (size_t)NTOK * KCS * 2;
constexpr size_t WS_YG = WS_QC + (size_t)NTOK * 384 * 2;
constexpr size_t WS_XB = WS_YG + (size_t)NTOK * 1024 * 2;
constexpr size_t WS_END = WS_XB + (size_t)NTOK * 1024 * 2;
static_assert(WS_END <= (size_t)256 * 1024 * 1024, "workspace map exceeds 256 MiB");
static_assert(WS_WIN % 256 == 0 && WS_U % 256 == 0 && WS_KC % 256 == 0 && WS_QC % 256 == 0 && WS_YG % 256 == 0 && WS_H % 256 == 0, "align");

constexpr int NT = 512;
constexpr int CW_DEP = 4096;
constexpr int LDS_CTLOFF = 147456;
constexpr int LDS_BYTES = LDS_CTLOFF + 64;
constexpr int NPHASE = 14;
constexpr int CW_QUEUE = 64;

struct Params {
    const float* in[24];
    float* out;
    unsigned char* ws;
    int ph_lo, ph_hi;
};

DI int tidx() { int t = threadIdx.x; asm volatile("" : "+v"(t)); return t; }
DI int bidx() { int b = blockIdx.x; asm volatile("" : "+s"(b)); return b; }
DI float bf2f(unsigned b) { return __uint_as_float(b << 16); }
DI unsigned pk2(float lo, float hi) { f32x2 v = {lo, hi}; bf16v2 b = __builtin_convertvector(v, bf16v2); return __builtin_bit_cast(unsigned, b); }
DI float shx(float v, int mask) {
    const int lane = tidx() & 63;
    return __uint_as_float((unsigned)__builtin_amdgcn_ds_bpermute(((lane ^ mask) << 2), (int)__float_as_uint(v)));
}
DI float wave_sum(float v) {
#pragma unroll
    for (int o = 32; o >= 1; o >>= 1) v += shx(v, o);
    return v;
}
DI float half_swap_max(float v) {
    auto rr = __builtin_amdgcn_permlane32_swap(__float_as_uint(v), __float_as_uint(v), false, false);
    return fmaxf(__uint_as_float(rr[0]), __uint_as_float(rr[1]));
}
DI float half_swap_sum(float v) {
    auto rr = __builtin_amdgcn_permlane32_swap(__float_as_uint(v), __float_as_uint(v), false, false);
    return __uint_as_float(rr[0]) + __uint_as_float(rr[1]);
}
DI float eps_() { float e = EPS; asm volatile("" : "+v"(e)); return e; }
DI int crow(int i, int hh) { return (i & 3) + 8 * (i >> 2) + 4 * hh; }
DI float siluf(float x) { return x * __builtin_amdgcn_rcpf(1.f + __builtin_amdgcn_exp2f(x * -1.44269504f)); }
DI void store_bf16x32(bf16_t* dst, const float* v) {
#pragma unroll
    for (int q = 0; q < 4; ++q) {
        u32x4 w = {pk2(v[8 * q], v[8 * q + 1]), pk2(v[8 * q + 2], v[8 * q + 3]), pk2(v[8 * q + 4], v[8 * q + 5]), pk2(v[8 * q + 6], v[8 * q + 7])};
        *(u32x4*)(dst + 8 * q) = w;
    }
}
DI void store_f32x32(float* dst, const float* v) {
#pragma unroll
    for (int q = 0; q < 8; ++q) { f32x4 w = {v[4 * q], v[4 * q + 1], v[4 * q + 2], v[4 * q + 3]}; *(f32x4*)(dst + 4 * q) = w; }
}
DI void rope32(float* v, const float* rope, int t) {
    const float* tr = rope + (t >> 6) * 16;
    const float* tc = rope + (t & 63) * 16;
#pragma unroll
    for (int a = 0; a < 2; ++a) {
        const float* tb = a ? tc : tr;
#pragma unroll
        for (int i = 0; i < 8; ++i) {
            const float c = tb[i], s = tb[8 + i];
            const float x0 = v[a * 16 + i], x1 = v[a * 16 + 8 + i];
            v[a * 16 + i] = x0 * c - x1 * s;
            v[a * 16 + 8 + i] = x1 * c + x0 * s;
        }
    }
}

template <int BM, class AF>
DI void gemm_mainloop(LAS unsigned char* lds, const AF& af, int m0, const bf16_t* __restrict__ Bt, int ldb, int n0, int K, f32x16 (&acc)[BM / 128][2]) {
    constexpr int NA = BM * 8 / NT, NB = 128 * 8 / NT, MI = BM / 128;
    constexpr int STAGE = (BM + 128) * 128;
    const int tid = tidx(), lane = tid & 63, r32 = lane & 31, hh = lane >> 5;
    const int w = __builtin_amdgcn_readfirstlane(tid >> 6), wr = w >> 1, wc = w & 1;
    const bf16_t* ap[NA];
    const bf16_t* bp[NB];
#pragma unroll
    for (int i = 0; i < NA; ++i) { const int p = tid + NT * i, row = p >> 3, cs = (p & 7) ^ ((row >> 1) & 7); ap[i] = af.row(m0 + row) + cs * 8; }
#pragma unroll
    for (int i = 0; i < NB; ++i) { const int p = tid + NT * i, row = p >> 3, cs = (p & 7) ^ ((row >> 1) & 7); bp[i] = Bt + (size_t)(n0 + row) * ldb + cs * 8; }
#pragma unroll
    for (int mi = 0; mi < MI; ++mi)
#pragma unroll
        for (int ni = 0; ni < 2; ++ni)
#pragma unroll
            for (int i = 0; i < 16; ++i) acc[mi][ni][i] = 0.f;
    const int nk = K / 64;
    const int xr = (r32 >> 1) & 7;
    const int arow = (wr * (BM / 4) + r32) * 128, brow = (wc * 64 + r32) * 128;
    auto stage = [&](int s, int kt) {
        LAS unsigned char* sa = lds + s * STAGE;
        LAS unsigned char* sb = sa + BM * 128;
#pragma unroll
        for (int i = 0; i < NA; ++i)
            __builtin_amdgcn_global_load_lds((const GAS void*)(ap[i] + kt * 64), (LAS void*)(sa + (w * 64 + NT * i) * 16), 16, 0, 0);
#pragma unroll
        for (int i = 0; i < NB; ++i)
            __builtin_amdgcn_global_load_lds((const GAS void*)(bp[i] + kt * 64), (LAS void*)(sb + (w * 64 + NT * i) * 16), 16, 0, 0);
    };
    stage(0, 0);
    for (int kt = 0; kt < nk; ++kt) {
        asm volatile("s_waitcnt vmcnt(0)" ::: "memory");
        __syncthreads();
        if (kt + 1 < nk) stage((kt + 1) & 1, kt + 1);
        LAS const unsigned char* sa = lds + (kt & 1) * STAGE;
        LAS const unsigned char* sb = sa + BM * 128;
#pragma unroll
        for (int kk = 0; kk < 4; ++kk) {
            const int co = (((kk * 2 + hh) ^ xr) << 4);
            bf16x8 a[MI], b[2];
#pragma unroll
            for (int mi = 0; mi < MI; ++mi) a[mi] = *(LAS const bf16x8*)(sa + arow + mi * 32 * 128 + co);
#pragma unroll
            for (int ni = 0; ni < 2; ++ni) b[ni] = *(LAS const bf16x8*)(sb + brow + ni * 32 * 128 + co);
#pragma unroll
            for (int mi = 0; mi < MI; ++mi)
#pragma unroll
                for (int ni = 0; ni < 2; ++ni) acc[mi][ni] = __builtin_amdgcn_mfma_f32_32x32x16_bf16(a[mi], b[ni], acc[mi][ni], 0, 0, 0);
        }
    }
    __syncthreads();
}

template <class EPI>
DI void staged_epilogue(LAS unsigned char* lds, f32x16 (&acc)[2][2], int m0, int n0, const EPI& epi) {
    const int tid = tidx(), lane = tid & 63, r32 = lane & 31, hh = lane >> 5;
    const int w = __builtin_amdgcn_readfirstlane(tid >> 6), wr = w >> 1, wc = w & 1;
    LAS float* st = (LAS float*)lds;
#pragma unroll
    for (int half = 0; half < 2; ++half) {
        if ((wr >> 1) == half) {
#pragma unroll
            for (int mi = 0; mi < 2; ++mi)
#pragma unroll
                for (int ni = 0; ni < 2; ++ni)
#pragma unroll
                    for (int i = 0; i < 16; ++i) st[((wr & 1) * 64 + mi * 32 + crow(i, hh)) * 132 + wc * 64 + ni * 32 + r32] = acc[mi][ni][i];
        }
        __syncthreads();
        {
            const int row = tid >> 2, ch = tid & 3;
            float v[32];
#pragma unroll
            for (int q = 0; q < 8; ++q) {
                const f32x4 t = *(LAS const f32x4*)(st + row * 132 + ch * 32 + q * 4);
                v[4 * q] = t[0]; v[4 * q + 1] = t[1]; v[4 * q + 2] = t[2]; v[4 * q + 3] = t[3];
            }
            epi(m0 + half * 128 + row, (n0 >> 5) + ch, v);
        }
        __syncthreads();
    }
}

DI void p0_mod_item(const Params& P, LAS unsigned char* lds, int item) {
    const int l = item / 48, n0 = (item % 48) * 64, tid = tidx();
    LAS float* sc = (LAS float*)lds;
    LAS float* red = sc + 5 * 1024;
    const float* c = P.in[8];
    const float* cctx = P.in[9];
    for (int idx = tid; idx < 5 * 1024; idx += NT) {
        const int j = idx >> 10, k = idx & 1023;
        const float x = (j == 0) ? cctx[k] : c[(j - 1) * 1024 + k];
        sc[idx] = x / (1.f + expf(-x));
    }
    __syncthreads();
    const int c4 = (tid & 15) * 4, kg = tid >> 4;
    const float* wp = P.in[10] + (size_t)l * 1024 * 3072 + (size_t)(kg * 32) * 3072 + n0 + c4;
    f32x4 a0 = {0.f, 0.f, 0.f, 0.f}, a1 = a0, a2 = a0, a3 = a0, a4 = a0;
#pragma unroll
    for (int h = 0; h < 2; ++h) {
        f32x4 w[16];
#pragma unroll
        for (int k = 0; k < 16; ++k) w[k] = *(const f32x4*)(wp + (size_t)(h * 16 + k) * 3072);
#pragma unroll
        for (int k = 0; k < 16; ++k) {
            const int kk = kg * 32 + h * 16 + k;
            a0 += sc[kk] * w[k]; a1 += sc[1024 + kk] * w[k]; a2 += sc[2048 + kk] * w[k]; a3 += sc[3072 + kk] * w[k]; a4 += sc[4096 + kk] * w[k];
        }
    }
    *(LAS f32x4*)(red + (kg * 5 + 0) * 64 + c4) = a0; *(LAS f32x4*)(red + (kg * 5 + 1) * 64 + c4) = a1; *(LAS f32x4*)(red + (kg * 5 + 2) * 64 + c4) = a2;
    *(LAS f32x4*)(red + (kg * 5 + 3) * 64 + c4) = a3; *(LAS f32x4*)(red + (kg * 5 + 4) * 64 + c4) = a4;
    __syncthreads();
    float* mod = (float*)(P.ws + WS_MOD);
    for (int idx = tid; idx < 320; idx += NT) {
        const int j = idx >> 6, cc = idx & 63;
        float s = P.in[11][l * 3072 + n0 + cc];
#pragma unroll 8
        for (int g = 0; g < 32; ++g) s += red[(g * 5 + j) * 64 + cc];
        mod[(l * 5 + j) * 3072 + n0 + cc] = s;
    }
    asm volatile("s_waitcnt vmcnt(0)" ::: "memory");
    __syncthreads();
    if (l == 0 && tid == 0) {
        __builtin_amdgcn_fence(__ATOMIC_RELEASE, "agent");
        asm volatile("s_waitcnt vmcnt(0)" ::: "memory");
        (void)__hip_atomic_fetch_add((unsigned*)(P.ws + WS_CTL) + CW_DEP, 1u, __ATOMIC_RELAXED, __HIP_MEMORY_SCOPE_AGENT);
    }
}

DI void p0_transpose_item(LAS unsigned char* lds, const float* src, int N, int k0, int ns0, int nvalid, bf16_t* dst, int ldd, int nd0, const float* kscale) {
    LAS float* T = (LAS float*)lds;
    const int tid = tidx();
#pragma unroll
    for (int i = 0; i < 2; ++i) {
        const int idx = tid + NT * i, kk = idx >> 4, n4 = (idx & 15) * 4;
        f32x4 v = {0.f, 0.f, 0.f, 0.f};
        if (n4 < nvalid) v = *(const f32x4*)(src + (size_t)(k0 + kk) * N + ns0 + n4);
        const float s = kscale ? kscale[k0 + kk] : 1.f;
        T[kk * 65 + n4] = v[0] * s; T[kk * 65 + n4 + 1] = v[1] * s; T[kk * 65 + n4 + 2] = v[2] * s; T[kk * 65 + n4 + 3] = v[3] * s;
    }
    __syncthreads();
    {
        const int idx = tid, nn = idx >> 3, kc = idx & 7;
        float v[8];
#pragma unroll
        for (int j = 0; j < 8; ++j) v[j] = T[(kc * 8 + j) * 65 + nn];
        u32x4 wv = {pk2(v[0], v[1]), pk2(v[2], v[3]), pk2(v[4], v[5]), pk2(v[6], v[7])};
        *(u32x4*)(dst + (size_t)(nd0 + nn) * ldd + k0 + kc * 8) = wv;
    }
    __syncthreads();
}

DI void p0_transpose_batch4(LAS unsigned char* lds, const float* src, int N, int k0, int jt0, int jmax, bool win, bf16_t* dst, int ldd) {
    LAS float* T = (LAS float*)lds;
    const int tid = tidx();
    f32x4 v[4][2];
#pragma unroll
    for (int q = 0; q < 4; ++q) {
        const int j = jt0 + q;
        const int ns0 = !win ? 64 * j : (j < 38) ? 64 * j : (j < 58 ? 64 * j + 32 : 2432), nvalid = (win && j == 58) ? 32 : 64;
#pragma unroll
        for (int i = 0; i < 2; ++i) {
            const int idx = tid + NT * i, kk = idx >> 4, n4 = (idx & 15) * 4;
            v[q][i] = (f32x4){0.f, 0.f, 0.f, 0.f};
            if (j < jmax && n4 < nvalid) v[q][i] = *(const f32x4*)(src + (size_t)(k0 + kk) * N + ns0 + n4);
        }
    }
#pragma unroll
    for (int q = 0; q < 4; ++q)
#pragma unroll
        for (int i = 0; i < 2; ++i) {
            const int idx = tid + NT * i, kk = idx >> 4, n4 = (idx & 15) * 4;
            LAS float* Tq = T + q * 64 * 65;
            Tq[kk * 65 + n4] = v[q][i][0]; Tq[kk * 65 + n4 + 1] = v[q][i][1]; Tq[kk * 65 + n4 + 2] = v[q][i][2]; Tq[kk * 65 + n4 + 3] = v[q][i][3];
        }
    __syncthreads();
#pragma unroll
    for (int q = 0; q < 4; ++q) {
        if (jt0 + q < jmax) {
            const int nn = tid >> 3, kc = tid & 7;
            LAS const float* Tq = T + q * 64 * 65;
            float w[8];
#pragma unroll
            for (int j = 0; j < 8; ++j) w[j] = Tq[(kc * 8 + j) * 65 + nn];
            u32x4 wv = {pk2(w[0], w[1]), pk2(w[2], w[3]), pk2(w[4], w[5]), pk2(w[6], w[7])};
            *(u32x4*)(dst + (size_t)((jt0 + q) * 64 + nn) * ldd + k0 + kc * 8) = wv;
        }
    }
    __syncthreads();
}

DI void p0_convert_flat(const float* src, bf16_t* dst, int item) {
    const size_t e = (size_t)item * 4096 + tidx() * 8;
    const f32x4 a = *(const f32x4*)(src + e), b = *(const f32x4*)(src + e + 4);
    u32x4 wv = {pk2(a[0], a[1]), pk2(a[2], a[3]), pk2(b[0], b[1]), pk2(b[2], b[3])};
    *(u32x4*)(dst + e) = wv;
}

DI void win_copy_item(const Params& P, LAS unsigned char* lds, int l, int r) {
    const int kt = r / 15, jb = r % 15;
    p0_transpose_batch4(lds, P.in[13] + (size_t)l * 1024 * 3744, 3744, kt * 64, jb * 4, 59, true, (bf16_t*)(P.ws + WS_WIN) + (size_t)l * NPADW * 1024, 1024);
}
DI void p0_convert_flat4(const float* src, bf16_t* dst) {
    const size_t e0 = (size_t)tidx() * 8;
    f32x4 a[4], b[4];
#pragma unroll
    for (int q = 0; q < 4; ++q) { a[q] = *(const f32x4*)(src + e0 + q * 4096); b[q] = *(const f32x4*)(src + e0 + q * 4096 + 4); }
#pragma unroll
    for (int q = 0; q < 4; ++q) {
        u32x4 wv = {pk2(a[q][0], a[q][1]), pk2(a[q][2], a[q][3]), pk2(b[q][0], b[q][1]), pk2(b[q][2], b[q][3])};
        *(u32x4*)(dst + e0 + q * 4096) = wv;
    }
}
constexpr int LP_WIN = 240, LP_WOUT = 64, LP_CA = 32, LP_CKV = 16, LP_KPE = 16, LP_TOTAL = LP_WIN + LP_WOUT + 4 * LP_CA + LP_CKV + LP_KPE;
DI void layer_prep_item(const Params& P, LAS unsigned char* lds, int l, int it) {
    if (it < LP_WIN) { win_copy_item(P, lds, l, it); return; }
    it -= LP_WIN;
    if (it < LP_WOUT) {
        const int kt = it >> 2, jb = it & 3;
        p0_transpose_batch4(lds, P.in[22] + (size_t)l * 1024 * 1024, 1024, kt * 64, jb * 4, 16, false, (bf16_t*)(P.ws + WS_WOUT) + (size_t)l * 1024 * 1024, 1024);
        return;
    }
    it -= LP_WOUT;
    if (it < 4 * LP_CA) {
        const int which = it >> 5, r = it & 31, b = r >> 3, sub = r & 7;
        const size_t off = (size_t)(b * 4 + l) * 131072 + (size_t)sub * 16384;
        if (which == 0) p0_convert_flat4(P.in[2] + off, (bf16_t*)(P.ws + WS_CAK) + off);
        else if (which == 1) p0_convert_flat4(P.in[3] + off, (bf16_t*)(P.ws + WS_CAV) + off);
        else if (which == 2) p0_convert_flat4(P.in[6] + off, (bf16_t*)(P.ws + WS_CDK) + off);
        else p0_convert_flat4(P.in[7] + off, (bf16_t*)(P.ws + WS_CDV) + off);
        return;
    }
    it -= 4 * LP_CA;
    if (it < LP_CKV) {
        const int b = it >> 2, sub = it & 3;
        const size_t off = (size_t)(b * 4 + l) * 65536 + (size_t)sub * 16384;
        p0_convert_flat4(P.in[4] + off, (bf16_t*)(P.ws + WS_CKVC) + off);
        return;
    }
    it -= LP_CKV;
    {
        const int b = it >> 2, sub = it & 3;
        const size_t e = (size_t)sub * 4096 + tidx() * 8;
        const float* src = P.in[5] + (size_t)(b * 4 + l) * 16384 + e;
        const f32x4 a = *(const f32x4*)(src), bq = *(const f32x4*)(src + 4);
        u32x4 wv = {pk2(a[0], a[1]), pk2(a[2], a[3]), pk2(bq[0], bq[1]), pk2(bq[2], bq[3])};
        const int j0 = (int)(e & 31), t = (int)(e >> 5);
        bf16_t* dst = (bf16_t*)(P.ws + WS_KCC) + ((size_t)(l * 4 + b) * 512 + t) * KCS + 64 + j0;
#pragma unroll
        for (int h = 0; h < 4; ++h) *(u32x4*)(dst + h * 160) = wv;
    }
}
constexpr int P0_MOD = 192, P0_WIN = 16 * 15  , P0_WOUT = 4 * 16 * 4, P0_WUQ = 4 * 4 * 6, P0_WUKV = 4 * 2 * 8,
              P0_CA = 512, P0_CKV = 256, P0_KPE = 64, P0_MISC = 1;
constexpr int P0_TOTAL = P0_MOD + P0_WIN + P0_WOUT + P0_WUQ + P0_WUKV + 4 * P0_CA + P0_CKV + P0_KPE + P0_MISC;

DI void phase0(const Params& P, LAS unsigned char* lds) {
    constexpr int P0_ALL = P0_MOD + LP_TOTAL + P0_WUQ + P0_WUKV + 1;
    for (int it = bidx(); it < P0_ALL; it += gridDim.x) {
        int item = it;
        if (item < P0_MOD) { p0_mod_item(P, lds, item); continue; }
        item -= P0_MOD;
        if (item < LP_TOTAL) { layer_prep_item(P, lds, 0, item); continue; }
        item -= LP_TOTAL;
        if (item < P0_WUQ) {
            const int l = item / 24, r = item % 24, kt = r / 6, j = r % 6;
            p0_transpose_item(lds, P.in[18] + (size_t)l * 256 * 384, 384, kt * 64, j * 64, 64, (bf16_t*)(P.ws + WS_WUQ) + (size_t)l * 384 * 256, 256, j * 64, P.in[17] + l * 256);
            continue;
        }
        item -= P0_WUQ;
        if (item < P0_WUKV) {
            const int l = item >> 4, r = item & 15, kt = r >> 3, j = r & 7;
            p0_transpose_item(lds, P.in[20] + (size_t)l * 128 * 512, 512, kt * 64, j * 64, 64, (bf16_t*)(P.ws + WS_WUKV) + (size_t)l * 512 * 128, 128, j * 64, nullptr);
            continue;
        }
        {
            const int tid = tidx();
            float* rope = (float*)(P.ws + WS_ROPE);
            for (int idx = tid; idx < 512; idx += NT) {
                const int pos = idx >> 3, i = idx & 7;
                const float inv = 1.0f / powf(10000.f, (float)(2 * i) / 16.f);
                const float ang = (float)pos * inv;
                rope[pos * 16 + i] = cosf(ang);
                rope[pos * 16 + 8 + i] = sinf(ang);
            }
            if (tid < 4) {
                const float* lv = P.in[14] + tid * 128;
                float s1 = 0.f, s2 = 0.f;
                for (int d = 0; d < 32; ++d) { s1 += lv[d] * lv[32 + d]; s2 += lv[64 + d] * lv[96 + d]; }
                const float li = 0.8f - 0.6f * expf(-0.3f * (float)tid);
                float* lam = (float*)(P.ws + WS_LAM);
                lam[tid * 2] = expf(s1) - expf(s2) + li;
                lam[tid * 2 + 1] = li;
            }
        }
    }
}

DI const float* xrow_ptr(const Params& P, int layer, int row) {
    if (layer == 0) return (row < NCTX) ? P.in[0] + (size_t)row * DM : P.in[1] + (size_t)(row - NCTX) * DM;
    return P.out + (size_t)row * DM;
}
DI void phaseN_rows(const Params& P, int layer, int row0, int rend, int rstep) {
    const int lane = tidx() & 63, w = tidx() >> 6;
    const float* g = P.in[12] + layer * DM;
    bf16_t* H = (bf16_t*)(P.ws + WS_H);
    for (int rb = row0; rb < rend; rb += rstep) {
        const int mi = (rb < NCTX) ? 0 : 1 + ((rb - NCTX) >> 11);
        const float* mod = (const float*)(P.ws + WS_MOD) + (size_t)(layer * 5 + mi) * 3072;
        f32x4 ca[4], cb[4];
#pragma unroll
        for (int i = 0; i < 4; ++i) {
            const int n = lane * 4 + 256 * i;
            const f32x4 gg = *(const f32x4*)(g + n), sc = *(const f32x4*)(mod + 1024 + n);
            cb[i] = *(const f32x4*)(mod + n);
            ca[i] = gg * (1.f + sc);
        }
        const int r4 = rb + 4 * w;
        f32x4 v[4][4];
        if (layer == 0) {
#pragma unroll
            for (int q = 0; q < 4; ++q) {
                const float* x = xrow_ptr(P, 0, r4 + q);
#pragma unroll
                for (int i = 0; i < 4; ++i) v[q][i] = *(const f32x4*)(x + lane * 4 + 256 * i);
            }
        } else {
            u32x2 xv[4][4];
#pragma unroll
            for (int q = 0; q < 4; ++q) {
                const bf16_t* x = (const bf16_t*)(P.ws + WS_XB) + (size_t)(r4 + q) * DM;
#pragma unroll
                for (int i = 0; i < 4; ++i) xv[q][i] = *(const u32x2*)(x + lane * 4 + 256 * i);
            }
#pragma unroll
            for (int q = 0; q < 4; ++q)
#pragma unroll
                for (int i = 0; i < 4; ++i) v[q][i] = (f32x4){bf2f(xv[q][i][0] & 0xffffu), bf2f(xv[q][i][0] >> 16), bf2f(xv[q][i][1] & 0xffffu), bf2f(xv[q][i][1] >> 16)};
        }
        float ss[4];
#pragma unroll
        for (int q = 0; q < 4; ++q) {
            float a = 0.f;
#pragma unroll
            for (int i = 0; i < 4; ++i) a += v[q][i][0] * v[q][i][0] + v[q][i][1] * v[q][i][1] + v[q][i][2] * v[q][i][2] + v[q][i][3] * v[q][i][3];
            ss[q] = a;
        }
#pragma unroll
        for (int o = 32; o >= 1; o >>= 1) {
#pragma unroll
            for (int q = 0; q < 4; ++q) ss[q] += shx(ss[q], o);
        }
#pragma unroll
        for (int q = 0; q < 4; ++q) {
            const float r = rsqrtf(ss[q] * (1.f / 1024.f) + eps_());
#pragma unroll
            for (int i = 0; i < 4; ++i) {
                const f32x4 o = v[q][i] * r * ca[i] + cb[i];
                u32x2 wv = {pk2(o[0], o[1]), pk2(o[2], o[3])};
                *(u32x2*)(H + (size_t)(r4 + q) * DM + lane * 4 + 256 * i) = wv;
            }
        }
    }
}
DI void phaseN(const Params& P, int layer) { phaseN_rows(P, layer, bidx() * 32, NTOK, gridDim.x * 32); }
DI void phaseFinal_rows(const Params& P, int row0, int rend, int rstep) {
    const int lane = tidx() & 63, w = tidx() >> 6;
    const float* g = P.in[23];
    f32x4 cg[4];
#pragma unroll
    for (int i = 0; i < 4; ++i) cg[i] = *(const f32x4*)(g + lane * 4 + 256 * i);
    for (int rb = row0; rb < rend; rb += rstep) {
        const int r4 = rb + 4 * w;
        f32x4 v[4][4];
#pragma unroll
        for (int q = 0; q < 4; ++q) {
            const float* x = P.out + (size_t)(r4 + q) * DM;
#pragma unroll
            for (int i = 0; i < 4; ++i) v[q][i] = *(const f32x4*)(x + lane * 4 + 256 * i);
        }
        float ss[4];
#pragma unroll
        for (int q = 0; q < 4; ++q) {
            float a = 0.f;
#pragma unroll
            for (int i = 0; i < 4; ++i) a += v[q][i][0] * v[q][i][0] + v[q][i][1] * v[q][i][1] + v[q][i][2] * v[q][i][2] + v[q][i][3] * v[q][i][3];
            ss[q] = a;
        }
#pragma unroll
        for (int o = 32; o >= 1; o >>= 1) {
#pragma unroll
            for (int q = 0; q < 4; ++q) ss[q] += shx(ss[q], o);
        }
#pragma unroll
        for (int q = 0; q < 4; ++q) {
            const float r = rsqrtf(ss[q] * (1.f / 1024.f) + eps_());
#pragma unroll
            for (int i = 0; i < 4; ++i) *(f32x4*)(P.out + (size_t)(r4 + q) * DM + lane * 4 + 256 * i) = v[q][i] * r * cg[i];
        }
    }
}

namespace pg8 {
#define PG8_LAS __attribute__((address_space(3)))
typedef unsigned short bf16_t;
typedef short bf16x8 __attribute__((ext_vector_type(8)));
typedef float f32x4 __attribute__((ext_vector_type(4)));
typedef unsigned u32x4 __attribute__((ext_vector_type(4)));
constexpr int BM = 256, BK = 64, HALF = 128, HTB = HALF * BK * 2  , STAGE_BYTES = 8 * HTB, NXCD = 8, WGM = 8;

__host__ __device__ __forceinline__ int lds_byte(int r, int c) { const int st = (r >> 4) * 2 + (c >> 5), rr = r & 15, cc = c & 31, ob = rr * 64 + cc * 2; return st * 1024 + (ob ^ (((ob >> 9) & 1) << 5)); }
__host__ __device__ __forceinline__ void stage_rc(int b, int& R, int& C) { const int st = b / 1024, sb = b % 1024, swz = sb ^ (((sb >> 9) & 1) << 5); R = (st >> 1) * 16 + swz / 64; C = (st & 1) * 32 + (swz % 64) / 2; }
__host__ __device__ __forceinline__ int perm32(int rho) { const int n = rho >> 4, i = rho & 15; return 8 * (i >> 2) + 4 * n + (i & 3); }

struct Unit { int pm, pn; };
struct Gemm { const bf16_t* A; const bf16_t* Bt; int M, N, K; int lda; };

struct StaticOrder {
    int nM, nN, nwg, G, c;
    __host__ __device__ void init(int M, int N, int G_, int c_) { nM = M / BM; nN = N / BM; nwg = nM * nN; G = G_; c = c_; }
    __host__ __device__ bool next(int i, Unit& u) const {
        const long L = (long)i * G + c; if (L >= nwg) return false;
        int wgid = (int)L; { const int q = nwg / NXCD, r = nwg % NXCD, xcd = wgid % NXCD, off = wgid / NXCD; wgid = (xcd < r ? xcd * (q + 1) : r * (q + 1) + (xcd - r) * q) + off; }
        const int nig = WGM * nN, gid = wgid / nig, fm = gid * WGM, gsz = (nM - fm) < WGM ? (nM - fm) : WGM;
        u.pm = fm + ((wgid % nig) % gsz); u.pn = (wgid % nig) / gsz; return true;
    }
    __device__ __forceinline__ void a_ready(const Unit&) const {}
    __device__ __forceinline__ void done(const Unit&) const {}
};

template <class Epi, class Sched, bool ALIGN_EPI = false, bool SP2 = false>
__device__ __forceinline__ void gemm_phase(PG8_LAS unsigned char* lds, const Gemm g, const Sched& S, const Epi& E) {
    const int tid = tidx(), wid = __builtin_amdgcn_readfirstlane(tid >> 6), lane = tid & 63, wr = wid >> 2, wc = wid & 3, fr = lane & 15, fq = lane >> 4;
    const int K = g.K, nt = K / BK, LDA = g.lda ? g.lda : g.K;
    unsigned voffA[2], voffB[2];
#pragma unroll
    for (int i = 0; i < 2; ++i) { int R, C; stage_rc(tid * 16 + i * 8192, R, C); const int Rb = Epi::PERM ? ((R & ~31) + perm32(R & 31)) : R;
        voffA[i] = (unsigned)(R * LDA + C) * 2u; voffB[i] = (unsigned)(Rb * K + C) * 2u; }
    const size_t kstep = (size_t)(BK * 2);
    const size_t hstepB = (size_t)HALF * K * 2, hstepA = (size_t)HALF * LDA * 2;
    const size_t tstepB = 2 * hstepB, tstepA = 2 * hstepA;
    const unsigned ldsw = (unsigned)wid * 1024u;
    const int aoff = lds_byte(wr * 64 + fr, fq * 8), boff = lds_byte(wc * 32 + fr, fq * 8);
#define PG8_SA(b, h) (((b) * 2 + (h)) * HTB)
#define PG8_SB(b, h) ((4 + (b) * 2 + (h)) * HTB)
#define PG8_STAGE(bufoff, gbase, voff) do { _Pragma("unroll") for (int _i = 0; _i < 2; ++_i) \
        __builtin_amdgcn_global_load_lds((const unsigned*)((const char*)(gbase) + (voff)[_i]), (PG8_LAS unsigned*)(lds + (bufoff) + ldsw + _i * 8192), 16, 0, 0); } while (0)
#define PG8_LDA(dst, b, h) do { _Pragma("unroll") for (int m = 0; m < 4; ++m) _Pragma("unroll") for (int k = 0; k < 2; ++k) dst[m][k] = *(const PG8_LAS bf16x8*)(lds + PG8_SA(b, h) + aoff + m * 2048 + k * 1024); } while (0)
#define PG8_LDB(dst, b, h) do { _Pragma("unroll") for (int n = 0; n < 2; ++n) _Pragma("unroll") for (int k = 0; k < 2; ++k) dst[n][k] = *(const PG8_LAS bf16x8*)(lds + PG8_SB(b, h) + boff + n * 2048 + k * 1024); } while (0)
#define PG8_MMA(ai, bj, At, Bt) do { __builtin_amdgcn_s_setprio(1); _Pragma("unroll") for (int m = 0; m < 4; ++m) _Pragma("unroll") for (int n = 0; n < 2; ++n) _Pragma("unroll") for (int k = 0; k < 2; ++k) \
        acc[ai][bj][m][n] = __builtin_amdgcn_mfma_f32_16x16x32_bf16(Bt[n][k], At[m][k], acc[ai][bj][m][n], 0, 0, 0); __builtin_amdgcn_s_setprio(0); } while (0)
#define PG8_WAIT_V(n) asm volatile("s_waitcnt vmcnt(" #n ")" ::: "memory")
#define PG8_WAIT_L(n) asm volatile("s_waitcnt lgkmcnt(" #n ")" ::: "memory")
#define PG8_BAR __builtin_amdgcn_s_barrier()
#define PG8_SCHED __builtin_amdgcn_sched_barrier(0)
    Unit cur, nxt; int ui = 0;
    if (!S.next(0, cur)) return;
    f32x4 acc[2][2][4][2];
#pragma unroll
    for (int a = 0; a < 2; ++a)
#pragma unroll
        for (int b = 0; b < 2; ++b)
#pragma unroll
            for (int m = 0; m < 4; ++m)
#pragma unroll
                for (int n = 0; n < 2; ++n) acc[a][b][m][n] = (f32x4){0.f, 0.f, 0.f, 0.f};
    bf16x8 At[4][2], B0[2][2], B1[2][2];
    const char* cA = (const char*)g.A + (size_t)cur.pm * tstepA; const char* cB = (const char*)g.Bt + (size_t)cur.pn * tstepB;
    S.a_ready(cur);
    if constexpr (SP2) {
        PG8_STAGE(PG8_SB(0, 0), cB, voffB); PG8_STAGE(PG8_SB(0, 1), cB + hstepB, voffB); PG8_STAGE(PG8_SA(0, 0), cA, voffA); PG8_STAGE(PG8_SA(0, 1), cA + hstepA, voffA);
        if (wr == 1) PG8_BAR;
        PG8_WAIT_V(2); PG8_BAR;
        PG8_STAGE(PG8_SB(1, 0), cB + kstep, voffB); PG8_STAGE(PG8_SA(1, 0), cA + kstep, voffA); PG8_STAGE(PG8_SB(1, 1), cB + hstepB + kstep, voffB);
        PG8_WAIT_V(6); PG8_BAR;
    } else {
        PG8_STAGE(PG8_SB(0, 0), cB, voffB); PG8_STAGE(PG8_SA(0, 0), cA, voffA); PG8_STAGE(PG8_SB(0, 1), cB + hstepB, voffB); PG8_STAGE(PG8_SA(0, 1), cA + hstepA, voffA);
        if (wr == 1) PG8_BAR;
        PG8_WAIT_V(4); PG8_BAR;
        PG8_STAGE(PG8_SB(1, 0), cB + kstep, voffB); PG8_STAGE(PG8_SA(1, 0), cA + kstep, voffA); PG8_STAGE(PG8_SB(1, 1), cB + hstepB + kstep, voffB);
        PG8_WAIT_V(6); PG8_BAR;
    }
    for (;;) {
        const bool has_next = S.next(ui + 1, nxt);
        const char* nA = has_next ? (const char*)g.A + (size_t)nxt.pm * tstepA : cA; const char* nB = has_next ? (const char*)g.Bt + (size_t)nxt.pn * tstepB : cB;
        for (int t = 0; t < nt; t += 2) {
            const bool last = (t == nt - 2);
            const char* a1 = cA + (size_t)(t + 1) * kstep;
            const char* a2 = last ? nA : cA + (size_t)(t + 2) * kstep; const char* b2 = last ? nB : cB + (size_t)(t + 2) * kstep;
            const char* a3 = a2 + kstep; const char* b3 = b2 + kstep;
            if (last && has_next) S.a_ready(nxt);
            if constexpr (SP2) {
            PG8_LDB(B0, 0, 0); PG8_LDB(B1, 0, 1); PG8_SCHED; PG8_LDA(At, 0, 0); PG8_STAGE(PG8_SA(1, 1), a1 + hstepA, voffA);
            PG8_WAIT_V(8); PG8_WAIT_L(0); PG8_BAR; PG8_MMA(0, 0, At, B0); PG8_MMA(0, 1, At, B1); PG8_BAR; PG8_SCHED;
            PG8_LDA(At, 0, 1); PG8_STAGE(PG8_SB(0, 0), b2, voffB); PG8_STAGE(PG8_SB(0, 1), b2 + hstepB, voffB); PG8_STAGE(PG8_SA(0, 0), a2, voffA);
            PG8_WAIT_V(8); PG8_WAIT_L(0); PG8_BAR; PG8_MMA(1, 0, At, B0); PG8_MMA(1, 1, At, B1); PG8_BAR; PG8_SCHED;
            PG8_LDB(B0, 1, 0); PG8_LDB(B1, 1, 1); PG8_SCHED; PG8_LDA(At, 1, 0); PG8_STAGE(PG8_SA(0, 1), a2 + hstepA, voffA);
            PG8_WAIT_V(8); PG8_WAIT_L(0); PG8_BAR; PG8_MMA(0, 0, At, B0); PG8_MMA(0, 1, At, B1); PG8_BAR; PG8_SCHED;
            PG8_LDA(At, 1, 1); PG8_STAGE(PG8_SB(1, 0), b3, voffB); PG8_STAGE(PG8_SB(1, 1), b3 + hstepB, voffB); PG8_STAGE(PG8_SA(1, 0), a3, voffA);
            PG8_WAIT_V(8); PG8_WAIT_L(0); PG8_BAR; PG8_MMA(1, 0, At, B0); PG8_MMA(1, 1, At, B1); PG8_BAR; PG8_SCHED;
            } else {
            PG8_LDB(B0, 0, 0); PG8_SCHED; PG8_LDA(At, 0, 0); PG8_STAGE(PG8_SA(1, 1), a1 + hstepA, voffA);
            PG8_WAIT_L(8); PG8_BAR; PG8_WAIT_L(0); PG8_MMA(0, 0, At, B0); PG8_BAR; PG8_SCHED;
            PG8_LDB(B1, 0, 1); PG8_STAGE(PG8_SB(0, 0), b2, voffB);
            PG8_BAR; PG8_WAIT_L(0); PG8_MMA(0, 1, At, B1); PG8_BAR;
            PG8_LDA(At, 0, 1); PG8_STAGE(PG8_SA(0, 0), a2, voffA);
            PG8_BAR; PG8_WAIT_L(0); PG8_MMA(1, 0, At, B0); PG8_BAR; PG8_SCHED;
            PG8_STAGE(PG8_SB(0, 1), b2 + hstepB, voffB);
            PG8_WAIT_V(6); PG8_BAR; PG8_MMA(1, 1, At, B1); PG8_BAR;
            PG8_LDB(B0, 1, 0); PG8_SCHED; PG8_LDA(At, 1, 0); PG8_STAGE(PG8_SA(0, 1), a2 + hstepA, voffA);
            PG8_WAIT_L(8); PG8_BAR; PG8_WAIT_L(0); PG8_MMA(0, 0, At, B0); PG8_BAR; PG8_SCHED;
            PG8_LDB(B1, 1, 1); PG8_STAGE(PG8_SB(1, 0), b3, voffB);
            PG8_BAR; PG8_WAIT_L(0); PG8_MMA(0, 1, At, B1); PG8_BAR;
            PG8_LDA(At, 1, 1); PG8_STAGE(PG8_SA(1, 0), a3, voffA);
            PG8_BAR; PG8_WAIT_L(0); PG8_MMA(1, 0, At, B0); PG8_BAR; PG8_SCHED;
            PG8_STAGE(PG8_SB(1, 1), b3 + hstepB, voffB);
            PG8_WAIT_V(6); PG8_BAR; PG8_MMA(1, 1, At, B1); PG8_BAR;
            }
        }
        if constexpr (ALIGN_EPI) { if (wr == 0) PG8_BAR; }
        if constexpr (!Epi::AFTER_DRAIN) { E(acc, cur, wr, wc, fr, fq); S.done(cur); }
        if (!has_next) break;
#pragma unroll
        for (int a = 0; a < 2; ++a)
#pragma unroll
            for (int b = 0; b < 2; ++b)
#pragma unroll
                for (int m = 0; m < 4; ++m)
#pragma unroll
                    for (int n = 0; n < 2; ++n) acc[a][b][m][n] = (f32x4){0.f, 0.f, 0.f, 0.f};
        cur = nxt; cA = nA; cB = nB; ++ui;
        if constexpr (ALIGN_EPI) { if (wr == 1) PG8_BAR; }
    }
    PG8_WAIT_V(0);
    if constexpr (!ALIGN_EPI) { if (wr == 0) PG8_BAR; }
    PG8_BAR;
    if constexpr (Epi::AFTER_DRAIN) { E.fused(acc, cur, wr, wc, fr, fq, lds, wid, lane); S.done(cur); }
#undef PG8_SA
#undef PG8_SB
#undef PG8_STAGE
#undef PG8_LDA
#undef PG8_LDB
#undef PG8_MMA
#undef PG8_WAIT_V
#undef PG8_WAIT_L
#undef PG8_BAR
#undef PG8_SCHED
}
}


struct EpiP1G {
    static constexpr bool PERM = true, AFTER_DRAIN = false;
    const Params* pp; int l; LAS float* xl;
    static constexpr int ROPE_LDS = 139264;
    static DI void st8(bf16_t* p, const float* v) { u32x4 w = {pk2(v[0], v[1]), pk2(v[2], v[3]), pk2(v[4], v[5]), pk2(v[6], v[7])}; *(u32x4*)p = w; }
    static DI void st8wt(bf16_t* p, const float* v) { u32x4 w = {pk2(v[0], v[1]), pk2(v[2], v[3]), pk2(v[4], v[5]), pk2(v[6], v[7])}; asm volatile("global_store_dwordx4 %0, %1, off sc1\n\ts_nop 1" :: "v"(p), "v"(w) : "memory"); }
    static DI void sf8(float* p, const float* v) { f32x4 a = {v[0], v[1], v[2], v[3]}, b = {v[4], v[5], v[6], v[7]}; *(f32x4*)p = a; *(f32x4*)(p + 4) = b; }
    DI void rope8(float* v, int t, int fq) const {
        LAS const float* tb = (LAS const float*)(xl + (ROPE_LDS - 131072) / 4) + ((fq >> 1) ? (t & 63) : (t >> 6)) * 16;
        const f32x4 c0 = *(LAS const f32x4*)tb, c1 = *(LAS const f32x4*)(tb + 4), s0 = *(LAS const f32x4*)(tb + 8), s1 = *(LAS const f32x4*)(tb + 12);
#pragma unroll
        for (int j = 0; j < 8; ++j) {
            const float pv = shx(v[j], 16);
            const float c = j < 4 ? c0[j & 3] : c1[j & 3], sn = j < 4 ? s0[j & 3] : s1[j & 3];
            v[j] = (fq & 1) ? v[j] * c + pv * sn : v[j] * c - pv * sn;
        }
    }
    static DI unsigned bperm(int a, unsigned v) { return (unsigned)__builtin_amdgcn_ds_bpermute(a, (int)v); }
    static DI u32x4 pack8t(const float* v, int bsrc) {
        u32x4 w = {pk2(v[0], v[1]), pk2(v[2], v[3]), pk2(v[4], v[5]), pk2(v[6], v[7])};
        u32x4 o = {bperm(bsrc, w[0]), bperm(bsrc, w[1]), bperm(bsrc, w[2]), bperm(bsrc, w[3])};
        return o;
    }
    static DI void st8t(bf16_t* p, const float* v, int bsrc) { *(u32x4*)p = pack8t(v, bsrc); }
    static DI void st8wtt(bf16_t* p, const float* v, int bsrc) { const u32x4 w = pack8t(v, bsrc); asm volatile("global_store_dwordx4 %0, %1, off sc1\n\ts_nop 1" :: "v"(p), "v"(w) : "memory"); }
    static DI void sf8t(float* p, const float* v, int bsrc) {
        f32x4 a, b;
#pragma unroll
        for (int j = 0; j < 4; ++j) { a[j] = __uint_as_float(bperm(bsrc, __float_as_uint(v[j]))); b[j] = __uint_as_float(bperm(bsrc, __float_as_uint(v[4 + j]))); }
        *(f32x4*)p = a; *(f32x4*)(p + 4) = b;
    }
    template <int CLS, int BJ>
    DI void rows(const pg8::f32x4 (&acc)[2][2][4][2], const pg8::Unit& u, int wr, int wc, int fr, int fq, int c32) const {
        const bool lat = u.pm >= 16;
        bf16_t* const U = (bf16_t*)(pp->ws + WS_U); bf16_t* const KC = (bf16_t*)(pp->ws + WS_KC); float* const SSQ = (float*)(pp->ws + WS_SSQ);
        float* const out = pp->out; const float* const gkv = pp->in[19] + l * 128;
        (void)U; (void)KC; (void)SSQ; (void)out; (void)gkv;
        const int ln = fq * 16 + fr, fr2 = ln >> 2, fq2 = ln & 3, bsrc = (fq2 * 16 + fr2) * 4;
        if constexpr (CLS == 6) {
            if constexpr (BJ == 0) {
#pragma unroll
                for (int ai = 0; ai < 2; ++ai)
#pragma unroll
                    for (int m = 0; m < 4; ++m) {
                        const int rloc = ai * 128 + wr * 64 + m * 16 + fr;
                        float ss = 0.f;
#pragma unroll
                        for (int j = 0; j < 4; ++j) ss += acc[ai][BJ][m][0][j] * acc[ai][BJ][m][0][j] + acc[ai][BJ][m][1][j] * acc[ai][BJ][m][1][j];
                        ss += shx(ss, 16); ss += shx(ss, 32);
                        if (fq == 0) xl[rloc * 4 + wc] = ss;
                    }
                asm volatile("s_waitcnt lgkmcnt(0)" ::: "memory"); __builtin_amdgcn_s_barrier(); asm volatile("" ::: "memory");
                const float* gp = gkv + (c32 - 72) * 32 + fq * 8;
                const f32x4 g0 = *(const f32x4*)gp, g1 = *(const f32x4*)(gp + 4);
#pragma unroll
                for (int ai = 0; ai < 2; ++ai)
#pragma unroll
                    for (int m = 0; m < 4; ++m) {
                        const int rb = ai * 128 + wr * 64 + m * 16, rloc = rb + fr, rloc2 = rb + fr2;
                        const f32x4 pp = *(LAS const f32x4*)(xl + rloc * 4);
                        const float rr = rsqrtf((pp[0] + pp[1] + pp[2] + pp[3]) * (1.f / 128.f) + eps_());
                        float v[8];
#pragma unroll
                        for (int j = 0; j < 4; ++j) { v[j] = acc[ai][BJ][m][0][j] * rr * g0[j]; v[4 + j] = acc[ai][BJ][m][1][j] * rr * g1[j]; }
                        if (!lat) sf8t(out + O_SCKV + ((size_t)(u.pm * 4 + l) * 256 + rloc2) * 128 + (c32 - 72) * 32 + fq2 * 8, v, bsrc);
                        st8wtt(U + (size_t)(u.pm * 256 + rloc2) * USTR + c32 * 32 + fq2 * 8, v, bsrc);
                        asm volatile("" ::: "memory");
                    }
                asm volatile("s_waitcnt lgkmcnt(0)" ::: "memory"); __builtin_amdgcn_s_barrier(); asm volatile("" ::: "memory");
            }
        } else {
#pragma unroll
            for (int ai = 0; ai < 2; ++ai)
#pragma unroll
                for (int m = 0; m < 4; ++m) {
                    const int rb = ai * 128 + wr * 64 + m * 16, rloc = rb + fr, r = u.pm * 256 + rloc, rloc2 = rb + fr2, r2 = u.pm * 256 + rloc2;
                    float v[8];
#pragma unroll
                    for (int j = 0; j < 4; ++j) { v[j] = acc[ai][BJ][m][0][j]; v[4 + j] = acc[ai][BJ][m][1][j]; }
                    bf16_t* up = U + (size_t)r2 * USTR + c32 * 32 + fq2 * 8;
                    const int t = (r - NCTX) & 2047;
                    const size_t srow = (size_t)(u.pm * 4 + l) * 256 + rloc2;
                    if constexpr (CLS == 0) {
                        if (lat) rope8(v, t, fq);
#pragma unroll
                        for (int j = 0; j < 8; ++j) v[j] *= SC_A;
                        st8t(up, v, bsrc);
                    } else if constexpr (CLS == 1) {
                        if (lat) rope8(v, t, fq); else sf8t(out + O_SAK + srow * 256 + (c32 - 8) * 32 + fq2 * 8, v, bsrc);
                        st8t(up, v, bsrc);
                    } else if constexpr (CLS == 2) {
                        if (!lat) sf8t(out + O_SAV + srow * 256 + (c32 - 16) * 32 + fq2 * 8, v, bsrc);
                        st8t(up, v, bsrc);
                    } else if constexpr (CLS == 3) {
#pragma unroll
                        for (int j = 0; j < 8; ++j) v[j] = siluf(v[j]);
                        st8t(up, v, bsrc);
                    } else if constexpr (CLS == 4) {
                        st8t(up, v, bsrc);
                    } else if constexpr (CLS == 5) {
                        float ss = 0.f;
#pragma unroll
                        for (int j = 0; j < 8; ++j) ss += v[j] * v[j];
                        ss += shx(ss, 16); ss += shx(ss, 32);
                        if (fq == 0) __hip_atomic_store((unsigned*)(SSQ + (size_t)r * 8 + (c32 - 64)), __float_as_uint(ss), __ATOMIC_RELAXED, __HIP_MEMORY_SCOPE_AGENT);
                        st8wtt(up, v, bsrc);
                    } else if constexpr (CLS == 7) {
#pragma unroll
                        for (int j = 0; j < 8; ++j) v[j] *= SC_D;
                        st8t(up, v, bsrc);
                    } else if constexpr (CLS == 8) {
                        if (!lat) sf8t(out + O_SDK + srow * 256 + (c32 - 92) * 32 + fq2 * 8, v, bsrc);
                        st8t(up, v, bsrc);
                    } else if constexpr (CLS == 9) {
                        if (!lat) sf8t(out + O_SDV + srow * 256 + (c32 - 100) * 32 + fq2 * 8, v, bsrc);
                        st8t(up, v, bsrc);
                    } else if constexpr (CLS == 10) {
                        if (lat) rope8(v, t, fq); else sf8t(out + O_SKPE + srow * 32 + fq2 * 8, v, bsrc);
                        bf16_t* kr = KC + (size_t)r2 * KCS + 64 + fq2 * 8;
                        const u32x4 w = pack8t(v, bsrc);
#pragma unroll
                        for (int h = 0; h < 4; ++h) *(u32x4*)(kr + h * 160) = w;
                    }
                    asm volatile("" ::: "memory");
                }
        }
    }
    template <int BJ>
    DI void half(const pg8::f32x4 (&acc)[2][2][4][2], const pg8::Unit& u, int wr, int wc, int fr, int fq) const {
        const int c32 = u.pn * 8 + BJ * 4 + wc;
        if (c32 < 8) rows<0, BJ>(acc, u, wr, wc, fr, fq, c32);
        else if (c32 < 16) rows<1, BJ>(acc, u, wr, wc, fr, fq, c32);
        else if (c32 < 24) rows<2, BJ>(acc, u, wr, wc, fr, fq, c32);
        else if (c32 < 32 || (c32 >= 56 && c32 < 64) || (c32 >= 76 && c32 < 84) || (c32 >= 108 && c32 < 116)) rows<3, BJ>(acc, u, wr, wc, fr, fq, c32);
        else if (c32 < 56) rows<4, BJ>(acc, u, wr, wc, fr, fq, c32);
        else if (c32 < 72) rows<5, BJ>(acc, u, wr, wc, fr, fq, c32);
        else if (c32 < 76) rows<6, BJ>(acc, u, wr, wc, fr, fq, c32);
        else if (c32 < 92) rows<7, BJ>(acc, u, wr, wc, fr, fq, c32);
        else if (c32 < 100) rows<8, BJ>(acc, u, wr, wc, fr, fq, c32);
        else if (c32 < 108) rows<9, BJ>(acc, u, wr, wc, fr, fq, c32);
        else if (c32 == 116) rows<10, BJ>(acc, u, wr, wc, fr, fq, c32);
    }
    DI void operator()(const pg8::f32x4 (&acc)[2][2][4][2], const pg8::Unit& u, int wr, int wc, int fr, int fq) const {
        asm volatile("" : "+v"(fr), "+v"(fq));
        half<0>(acc, u, wr, wc, fr, fq);
        half<1>(acc, u, wr, wc, fr, fq);
    }
};


DI void store16_wt(void* p, f32x4 v) { asm volatile("global_store_dwordx4 %0, %1, off sc1\n\ts_nop 1" :: "v"(p), "v"(v)); }
DI void dep_signal(unsigned* ctr) {
    asm volatile("s_waitcnt vmcnt(0)" ::: "memory");
    __syncthreads();
    if (tidx() == 0) (void)__hip_atomic_fetch_add(ctr, 1u, __ATOMIC_RELAXED, __HIP_MEMORY_SCOPE_AGENT);
}
DI void dep_wait(unsigned* ctr, unsigned target) {
    if (tidx() == 0) {
        unsigned sp = 0;
        while (__hip_atomic_load(ctr, __ATOMIC_RELAXED, __HIP_MEMORY_SCOPE_AGENT) < target) {
            __builtin_amdgcn_s_sleep(2);
            if (++sp > (1u << 22)) break;
        }
        __builtin_amdgcn_fence(__ATOMIC_ACQUIRE, "agent");
        asm volatile("s_waitcnt vmcnt(0)" ::: "memory");
    }
    __syncthreads();
}

struct EpiP3G {
    static constexpr bool PERM = true, AFTER_DRAIN = false;
    const Params* pp; int layer;
    DI void operator()(const pg8::f32x4 (&acc)[2][2][4][2], const pg8::Unit& u, int wr, int wc, int fr, int fq) const {
        asm volatile("" : "+v"(fr), "+v"(fq));
        const float* const x0c = pp->in[0]; const float* const x0l = pp->in[1]; float* const out = pp->out; const float* const mod = (const float*)(pp->ws + WS_MOD);
        const int mi = (u.pm < 16) ? 0 : 1 + ((u.pm - 16) >> 3);
        const float* gate = mod + (size_t)(layer * 5 + mi) * 3072 + 2048;
        const int rbase = u.pm * 256 + wr * 64 + fr;
        bf16_t* const XBp = (bf16_t*)(pp->ws + WS_XB);
#pragma unroll
        for (int bj = 0; bj < 2; ++bj) {
            const int c8 = u.pn * 256 + bj * 128 + wc * 32 + fq * 8;
            const f32x4 g0 = *(const f32x4*)(gate + c8), g1 = *(const f32x4*)(gate + c8 + 4);
            if (layer == 0) {
                const float* xin0 = (u.pm < 16) ? x0c + (size_t)rbase * DM : x0l + (size_t)(rbase - NCTX) * DM;
                f32x4 xa[2][4], xq[2][4];
#pragma unroll
                for (int ai = 0; ai < 2; ++ai)
#pragma unroll
                    for (int m = 0; m < 4; ++m) { const float* xp = xin0 + (size_t)(ai * 128 + m * 16) * DM + c8; xa[ai][m] = *(const f32x4*)xp; xq[ai][m] = *(const f32x4*)(xp + 4); }
#pragma unroll
                for (int ai = 0; ai < 2; ++ai)
#pragma unroll
                    for (int m = 0; m < 4; ++m) {
                        const f32x4 a = xa[ai][m] + g0 * acc[ai][bj][m][0], b = xq[ai][m] + g1 * acc[ai][bj][m][1];
                        u32x4 wv = {pk2(a[0], a[1]), pk2(a[2], a[3]), pk2(b[0], b[1]), pk2(b[2], b[3])};
                        *(u32x4*)(XBp + (size_t)(rbase + ai * 128 + m * 16) * DM + c8) = wv;
                    }
            } else {
                u32x4 xv[2][4];
#pragma unroll
                for (int ai = 0; ai < 2; ++ai)
#pragma unroll
                    for (int m = 0; m < 4; ++m) xv[ai][m] = *(const u32x4*)(XBp + (size_t)(rbase + ai * 128 + m * 16) * DM + c8);
#pragma unroll
                for (int ai = 0; ai < 2; ++ai)
#pragma unroll
                    for (int m = 0; m < 4; ++m) {
                        const u32x4 w4 = xv[ai][m];
                        f32x4 a = {bf2f(w4[0] & 0xffffu), bf2f(w4[0] >> 16), bf2f(w4[1] & 0xffffu), bf2f(w4[1] >> 16)};
                        f32x4 b = {bf2f(w4[2] & 0xffffu), bf2f(w4[2] >> 16), bf2f(w4[3] & 0xffffu), bf2f(w4[3] >> 16)};
                        a = a + g0 * acc[ai][bj][m][0]; b = b + g1 * acc[ai][bj][m][1];
                        const size_t ro = (size_t)(rbase + ai * 128 + m * 16) * DM + c8;
                        if (layer + 1 < DEPTH) {
                            u32x4 wv = {pk2(a[0], a[1]), pk2(a[2], a[3]), pk2(b[0], b[1]), pk2(b[2], b[3])};
                            *(u32x4*)(XBp + ro) = wv;
                        } else {
                            *(f32x4*)(out + ro) = a;
                            *(f32x4*)(out + ro + 4) = b;
                        }
                    }
            }
        }
    }
};

struct ARowPlain { const bf16_t* base; int ld; DI const bf16_t* row(int m) const { return base + (size_t)m * ld; } };

struct EpiP1 {
    bf16_t* U; bf16_t* KC; float* SSQ; const float* rope; float* out; const float* gkv; int l;
    DI void operator()(int m, int c32, float* v) const {
        const bool lat = (m >= NCTX);
        const int t = (m - NCTX) & 2047;
        const size_t srow = lat ? 0 : ((size_t)((m >> 8) * 4 + l) * 256 + (m & 255));
        bf16_t* urow = U + (size_t)m * USTR + c32 * 32;
        if (c32 < 8) {
            if (lat) rope32(v, rope, t);
#pragma unroll
            for (int j = 0; j < 32; ++j) v[j] *= SC_A;
            store_bf16x32(urow, v);
        } else if (c32 < 16) {
            if (lat) rope32(v, rope, t); else store_f32x32(out + O_SAK + srow * 256 + (c32 - 8) * 32, v);
            store_bf16x32(urow, v);
        } else if (c32 < 24) {
            if (!lat) store_f32x32(out + O_SAV + srow * 256 + (c32 - 16) * 32, v);
            store_bf16x32(urow, v);
        } else if (c32 < 32 || (c32 >= 56 && c32 < 64) || (c32 >= 76 && c32 < 84) || (c32 >= 108 && c32 < 116)) {
#pragma unroll
            for (int j = 0; j < 32; ++j) v[j] = siluf(v[j]);
            store_bf16x32(urow, v);
        } else if (c32 < 56) {
            store_bf16x32(urow, v);
        } else if (c32 < 72) {
            float ss = 0.f;
#pragma unroll
            for (int j = 0; j < 32; ++j) ss += v[j] * v[j];
            SSQ[(size_t)m * 8 + (c32 - 64)] = ss;
            store_bf16x32(urow, v);
        } else if (c32 < 76) {
            float ss = 0.f;
#pragma unroll
            for (int j = 0; j < 32; ++j) ss += v[j] * v[j];
            ss += shx(ss, 1);
            ss += shx(ss, 2);
            const float r = rsqrtf(ss * (1.f / 128.f) + eps_());
            const float* gp = gkv + (c32 - 72) * 32;
#pragma unroll
            for (int j = 0; j < 32; ++j) v[j] = v[j] * r * gp[j];
            if (!lat) store_f32x32(out + O_SCKV + srow * 128 + (c32 - 72) * 32, v);
            store_bf16x32(urow, v);
        } else if (c32 < 92) {
#pragma unroll
            for (int j = 0; j < 32; ++j) v[j] *= SC_D;
            store_bf16x32(urow, v);
        } else if (c32 < 100) {
            if (!lat) store_f32x32(out + O_SDK + srow * 256 + (c32 - 92) * 32, v);
            store_bf16x32(urow, v);
        } else if (c32 < 108) {
            if (!lat) store_f32x32(out + O_SDV + srow * 256 + (c32 - 100) * 32, v);
            store_bf16x32(urow, v);
        } else if (c32 == 116) {
            if (lat) rope32(v, rope, t); else store_f32x32(out + O_SKPE + srow * 32, v);
            bf16_t* kr = KC + (size_t)m * KCS + 64;
#pragma unroll
            for (int h = 0; h < 4; ++h) store_bf16x32(kr + h * 160, v);
        }
    }
};

struct P1Order {
    int G, c; unsigned* dep;
    DI bool next(int i, pg8::Unit& u) const {
        const int L = i * G + c;
        if (L < 96) { u.pm = L >> 1; u.pn = 8 + (L & 1); return true; }
        const int L2 = L - 96;
        if (L2 >= 624) return false;
        constexpr int nM = 48, nN = 13, nwg = 624, NX = 8, WG = 8;
        int wgid = L2; { const int q = nwg / NX, xcd = wgid % NX, off = wgid / NX; wgid = xcd * q + off; }
        const int nig = WG * nN, gid = wgid / nig, fm = gid * WG, gsz = (nM - fm) < WG ? (nM - fm) : WG;
        u.pm = fm + ((wgid % nig) % gsz);
        const int pn = (wgid % nig) / gsz;
        u.pn = pn < 8 ? pn : pn + 2;
        return true;
    }
    DI void a_ready(const pg8::Unit&) const {}
    DI void done(const pg8::Unit& u) const {
        if (u.pn == 8 || u.pn == 9) {
            asm volatile("s_waitcnt vmcnt(0)" ::: "memory");
            __builtin_amdgcn_s_barrier();
            if (tidx() == 0) (void)__hip_atomic_fetch_add(dep + u.pm, 1u, __ATOMIC_RELAXED, __HIP_MEMORY_SCOPE_AGENT);
        }
    }
};
struct OneUnit {
    int pn;
    DI bool next(int i, pg8::Unit& u) const { if (i) return false; u.pm = 0; u.pn = pn; return true; }
    DI void a_ready(const pg8::Unit&) const {}
    DI void done(const pg8::Unit&) const {}
};
struct EpiQG {
    static constexpr bool PERM = true, AFTER_DRAIN = false;
    const Params* pp; int row0; LAS const float* rope;
    DI void operator()(const pg8::f32x4 (&acc)[2][2][4][2], const pg8::Unit& u, int wr, int wc, int fr, int fq) const {
        asm volatile("" : "+v"(fr), "+v"(fq));
        bf16_t* const QC = (bf16_t*)(pp->ws + WS_QC); const float* const SSQ = (const float*)(pp->ws + WS_SSQ);
#pragma unroll
        for (int bj = 0; bj < 2; ++bj) {
            const int c32 = u.pn * 8 + bj * 4 + wc;
            if (c32 < 12) {
                const bool ropec = (c32 % 3) == 2;
#pragma unroll
                for (int ai = 0; ai < 2; ++ai)
#pragma unroll
                    for (int m = 0; m < 4; ++m) {
                        const int r = row0 + ai * 128 + wr * 64 + m * 16 + fr;
                        const f32x4 s0 = *(const f32x4*)(SSQ + (size_t)r * 8), s1 = *(const f32x4*)(SSQ + (size_t)r * 8 + 4);
                        const float rr = rsqrtf((s0[0] + s0[1] + s0[2] + s0[3] + s1[0] + s1[1] + s1[2] + s1[3]) * (1.f / 256.f) + eps_());
                        float v[8];
#pragma unroll
                        for (int j = 0; j < 4; ++j) { v[j] = acc[ai][bj][m][0][j] * rr; v[4 + j] = acc[ai][bj][m][1][j] * rr; }
                        if (ropec && r >= NCTX) {
                            const int t = (r - NCTX) & 2047;
                            LAS const float* tb = rope + ((fq >> 1) ? (t & 63) : (t >> 6)) * 16;
                            const f32x4 c0 = *(LAS const f32x4*)tb, c1 = *(LAS const f32x4*)(tb + 4), sn0 = *(LAS const f32x4*)(tb + 8), sn1 = *(LAS const f32x4*)(tb + 12);
#pragma unroll
                            for (int j = 0; j < 8; ++j) {
                                const float pv = shx(v[j], 16);
                                const float c = j < 4 ? c0[j & 3] : c1[j & 3], sn = j < 4 ? sn0[j & 3] : sn1[j & 3];
                                v[j] = (fq & 1) ? v[j] * c + pv * sn : v[j] * c - pv * sn;
                            }
                        }
#pragma unroll
                        for (int j = 0; j < 8; ++j) v[j] *= SC_C;
                        EpiP1G::st8(QC + (size_t)r * 384 + c32 * 32 + fq * 8, v);
                        asm volatile("" ::: "memory");
                    }
            }
        }
    }
};
struct EpiKVG {
    static constexpr bool PERM = true, AFTER_DRAIN = false;
    bf16_t* dst0;
    DI void operator()(const pg8::f32x4 (&acc)[2][2][4][2], const pg8::Unit& u, int wr, int wc, int fr, int fq) const {
        asm volatile("" : "+v"(fr), "+v"(fq));
#pragma unroll
        for (int bj = 0; bj < 2; ++bj) {
            const int c32 = u.pn * 8 + bj * 4 + wc, head = c32 >> 2, part = c32 & 3;
            const int coff = head * 160 + (part < 2 ? part * 32 : 96 + (part - 2) * 32) + fq * 8;
#pragma unroll
            for (int ai = 0; ai < 2; ++ai)
#pragma unroll
                for (int m = 0; m < 4; ++m) {
                    const int rl = ai * 128 + wr * 64 + m * 16 + fr;
                    float v[8];
#pragma unroll
                    for (int j = 0; j < 4; ++j) { v[j] = acc[ai][bj][m][0][j]; v[4 + j] = acc[ai][bj][m][1][j]; }
                    EpiP1G::st8(dst0 + (size_t)rl * KCS + coff, v);
                }
        }
    }
};
struct PQUnit {
    int pm, pn;
    DI bool next(int i, pg8::Unit& u) const { if (i) return false; u.pm = pm; u.pn = pn; return true; }
    DI void a_ready(const pg8::Unit&) const {}
    DI void done(const pg8::Unit&) const {}
};
constexpr int NP1B_UNITS = 208;
DI void phaseP1(const Params& P, LAS unsigned char* lds, int layer, int phase_id) {
    unsigned* dep = (unsigned*)(P.ws + WS_CTL) + CW_DEP + 64 * phase_id;
    ((LAS f32x2*)(lds + EpiP1G::ROPE_LDS))[tidx()] = ((const f32x2*)(P.ws + WS_ROPE))[tidx()];
    __syncthreads();
    {
        pg8::Gemm g{(const bf16_t*)(P.ws + WS_H), (const bf16_t*)(P.ws + WS_WIN) + (size_t)layer * NPADW * 1024, NTOK, NPADW, 1024, 0};
        P1Order S{(int)gridDim.x, bidx(), dep};
        EpiP1G E{&P, layer, (LAS float*)(lds + 131072)};
        pg8::gemm_phase<EpiP1G, P1Order, true, true>(lds, g, S, E);
    }
    unsigned* qctr = (unsigned*)(P.ws + WS_CTL) + CW_QUEUE + 64 * phase_id;
    LAS volatile int* sitem = (LAS volatile int*)(lds + LDS_CTLOFF + 16);
    const bf16_t* U = (const bf16_t*)(P.ws + WS_U);
    for (;;) {
        if (tidx() == 0) *sitem = (int)atomicAdd(qctr, 1u);
        __syncthreads();
        const int c = *sitem;
        __syncthreads();
        if (c >= NP1B_UNITS) break;
        if (c < 96) {
            const int pm = c >> 1;
            dep_wait(dep + pm, 2u);
            pg8::Gemm g{U + (size_t)pm * 256 * USTR + U_CQ, (const bf16_t*)(P.ws + WS_WUQ) + (size_t)layer * 384 * 256, 256, 512, 256, USTR};
            OneUnit S{c & 1};
            EpiQG E{&P, pm * 256, (LAS const float*)(lds + EpiP1G::ROPE_LDS)};
            pg8::gemm_phase<EpiQG, OneUnit, true, false>(lds, g, S, E);
        } else {
            const bf16_t* A; bf16_t* dst; int lda;
            if (c < 192) {
                const int pm = (c - 96) >> 1;
                dep_wait(dep + pm, 2u);
                A = U + (size_t)pm * 256 * USTR + U_CKV; lda = USTR; dst = (bf16_t*)(P.ws + WS_KC) + (size_t)pm * 256 * KCS;
            } else {
                const int pq = (c - 192) >> 1, b = pq >> 1, half = pq & 1;
                A = (const bf16_t*)(P.ws + WS_CKVC) + ((size_t)(b * 4 + layer) * 512 + half * 256) * 128; lda = 128;
                dst = (bf16_t*)(P.ws + WS_KCC) + ((size_t)(layer * 4 + b) * 512 + half * 256) * KCS;
            }
            pg8::Gemm g{A, (const bf16_t*)(P.ws + WS_WUKV) + (size_t)layer * 512 * 128, 256, 512, 128, lda};
            OneUnit S{c & 1};
            EpiKVG E{dst};
            pg8::gemm_phase<EpiKVG, OneUnit, true, false>(lds, g, S, E);
        }
    }
}

struct EpiQ {
    bf16_t* QC; const float* SSQ; const float* rope;
    DI void operator()(int m, int c32, float* v) const {
        const f32x4 s0 = *(const f32x4*)(SSQ + (size_t)m * 8), s1 = *(const f32x4*)(SSQ + (size_t)m * 8 + 4);
        const float ss = s0[0] + s0[1] + s0[2] + s0[3] + s1[0] + s1[1] + s1[2] + s1[3];
        const float r = rsqrtf(ss * (1.f / 256.f) + eps_());
#pragma unroll
        for (int j = 0; j < 32; ++j) v[j] *= r;
        if ((c32 % 3) == 2 && m >= NCTX) rope32(v, rope, (m - NCTX) & 2047);
#pragma unroll
        for (int j = 0; j < 32; ++j) v[j] *= SC_C;
        store_bf16x32(QC + (size_t)m * 384 + c32 * 32, v);
    }
};
struct ARowKV {
    const bf16_t* U; const bf16_t* ckvc; int l;
    DI const bf16_t* row(int m) const {
        if (m < NTOK) return U + (size_t)m * USTR + U_CKV;
        const int mm = m - NTOK, b = mm >> 9, t = mm & 511;
        return ckvc + ((size_t)(b * 4 + l) * 512 + t) * 128;
    }
};
struct EpiKV {
    bf16_t* KC; bf16_t* KCC; int l;
    DI void operator()(int m, int c32, float* v) const {
        const int head = c32 >> 2, part = c32 & 3;
        bf16_t* dst;
        if (m < NTOK) dst = KC + (size_t)m * KCS;
        else { const int mm = m - NTOK, b = mm >> 9, t = mm & 511; dst = KCC + ((size_t)(l * 4 + b) * 512 + t) * KCS; }
        dst += head * 160 + (part < 2 ? part * 32 : 96 + (part - 2) * 32);
        store_bf16x32(dst, v);
    }
};
struct AttnDesc {
    const bf16_t* q; int qs;
    const bf16_t* k0; const bf16_t* v0; int ks0, vs0, nt0;
    const bf16_t* k1; const bf16_t* v1; int ks1, vs1;
    int nt;
    bf16_t* out; const bf16_t* sz;
    float lam, oml; const float* subg;
    const float* rpb; int qrow0, rs;
};

template <int MODE, bool FAST>
DI bool attn_unit(const AttnDesc& d, LAS unsigned char* lds, unsigned* qctr, unsigned* pend) {
    constexpr int DQK = (MODE == 1) ? 96 : 64;
    constexpr int NMAP = (MODE == 0) ? 2 : 1;
    constexpr int NKK = DQK / 16;
    constexpr int KSTR = DQK * 2 + 16;
    constexpr int NKC = DQK / 8;
    constexpr int NKL = (64 * NKC + NT - 1) / NT;
    constexpr int KBUF = 64 * KSTR;
    constexpr int VOFF = 2 * 64 * 208;
    constexpr int BOFF = VOFF + 16384;
    constexpr float THR = 6.f;
    const int tid = tidx(), lane = tid & 63, r32 = lane & 31, hh = lane >> 5;
    const int w = __builtin_amdgcn_readfirstlane(tid >> 6);

    bf16x8 qf[NKK];
    {
        const bf16_t* qrow = d.q + (size_t)(w * 32 + r32) * d.qs + hh * 8;
#pragma unroll
        for (int kk = 0; kk < NKK; ++kk) qf[kk] = *(const bf16x8*)(qrow + kk * 16);
    }
    const bool has_bias = (MODE == 2) && (d.rpb != nullptr);
    if (MODE == 2 && has_bias) {
        LAS float* bt = (LAS float*)(lds + BOFF);
        for (int idx = tid; idx < 15 * 31; idx += NT) bt[(idx / 31) * 32 + (idx % 31)] = d.rpb[idx] * LOG2E;
    }
    float m[NMAP], l[NMAP];
    f32x16 o[NMAP][2];
#pragma unroll
    for (int mp = 0; mp < NMAP; ++mp) {
        m[mp] = NEGBIG; l[mp] = 0.f;
#pragma unroll
        for (int i = 0; i < 16; ++i) { o[mp][0][i] = 0.f; o[mp][1][i] = 0.f; }
    }
    u32x4 kregA[NKL], vregA, kregB[NKL], vregB;
    auto load_tile = [&](int t, u32x4 (&kr)[NKL], u32x4& vr) {
        const bool s0 = t < d.nt0;
        const int tt = s0 ? t : t - d.nt0;
        const int ks = s0 ? d.ks0 : d.ks1, vs = s0 ? d.vs0 : d.vs1;
        const bf16_t* kb = (s0 ? d.k0 : d.k1) + (size_t)tt * 64 * ks;
        const bf16_t* vb = (s0 ? d.v0 : d.v1) + (size_t)tt * 64 * vs;
#pragma unroll
        for (int i = 0; i < NKL; ++i) { const int c = tid + NT * i, row = c / NKC, ch = c % NKC; if (c < 64 * NKC) kr[i] = *(const u32x4*)(kb + (size_t)row * ks + ch * 8); }
        { const int row = tid >> 3, ch = tid & 7; vr = *(const u32x4*)(vb + (size_t)row * vs + ch * 8); }
    };
    auto store_tile = [&](int buf, const u32x4 (&kr)[NKL], const u32x4& vr) {
        LAS unsigned char* kd = lds + buf * KBUF;
        LAS unsigned char* vd = lds + VOFF + buf * 8192;
#pragma unroll
        for (int i = 0; i < NKL; ++i) { const int c = tid + NT * i, row = c / NKC, ch = c % NKC; if (c < 64 * NKC) *(LAS u32x4*)(kd + row * KSTR + ch * 16) = kr[i]; }
        { const int row = tid >> 3, ch = tid & 7; *(LAS u32x4*)(vd + row * 128 + ((ch * 16) ^ (((row >> 1) & 1) << 6))) = vr; }
    };
    const int q4 = (lane & 15) >> 2, p4 = lane & 3, g16 = (lane >> 4) & 1, xs = (q4 >> 1) & 1;
    const int vlane = (4 * hh + q4) * 128 + g16 * 32 + p4 * 8;
    const int rq = d.qrow0 + (w >> 1), qc = (w & 1) * 32 + r32;
    const int rst = min(max(rq - 4, 0), 24), wst = min(max(qc - 8, 0), 48);

    auto tile_body = [&](int t, int cur) {
        bool valid = true;
        int dy = 0;
        if (MODE == 2 && has_bias && t >= d.nt0) { const int krow = d.rs + (t - d.nt0); valid = (krow >= rst) && (krow < rst + 8); dy = krow - rq + 7; }
        if (valid) {
            LAS const unsigned char* kb = lds + cur * KBUF;
            LAS const unsigned char* vb = lds + VOFF + cur * 8192;
            bf16x8 kf[2][NKK];
#pragma unroll
            for (int sub = 0; sub < 2; ++sub)
#pragma unroll
                for (int kk = 0; kk < NKK; ++kk) kf[sub][kk] = *(LAS const bf16x8*)(kb + (sub * 32 + r32) * KSTR + kk * 32 + hh * 16);
            bf16x8 vfr[2][2][2];
            auto vread = [&](int sub, int st, int dvb) {
                LAS const unsigned char* va = vb + vlane + (sub * 32 + st * 16) * 128 + ((dvb ^ xs) * 64);
                const s16x4 lo = __builtin_bit_cast(s16x4, __builtin_amdgcn_ds_read_tr16_b64_v4i16((LAS s16x4*)(va)));
                const s16x4 hi = __builtin_bit_cast(s16x4, __builtin_amdgcn_ds_read_tr16_b64_v4i16((LAS s16x4*)(va + 8 * 128)));
                const bf16x8 vf = {lo[0], lo[1], lo[2], lo[3], hi[0], hi[1], hi[2], hi[3]};
                return vf;
            };
#pragma unroll
            for (int st = 0; st < 2; ++st)
#pragma unroll
                for (int dvb = 0; dvb < 2; ++dvb) vfr[0][st][dvb] = vread(0, st, dvb);
            __builtin_amdgcn_sched_barrier(0);
            bf16x8 pf[NMAP][2][2];
#pragma unroll
            for (int mp = 0; mp < NMAP; ++mp) {
                f32x16 s[2];
#pragma unroll
                for (int sub = 0; sub < 2; ++sub) {
#pragma unroll
                    for (int i = 0; i < 16; ++i) s[sub][i] = 0.f;
#pragma unroll
                    for (int k2 = 0; k2 < NKK / NMAP; ++k2) {
                        const int kk = mp * (NKK / NMAP) + k2;
                        s[sub] = __builtin_amdgcn_mfma_f32_32x32x16_bf16(kf[sub][kk], qf[kk], s[sub], 0, 0, 0);
                    }
                }
                if (MODE == 2 && has_bias && t >= d.nt0) {
                    int kofs = 4 * hh - wst, bidx = dy * 32 + 4 * hh - qc + 15;
                    asm volatile("" : "+v"(kofs), "+v"(bidx));
                    LAS const float* bt = (LAS const float*)(lds + BOFF) + bidx;
#pragma unroll
                    for (int sub = 0; sub < 2; ++sub)
#pragma unroll
                        for (int i = 0; i < 16; ++i) {
                            const int kci = sub * 32 + (i & 3) + 8 * (i >> 2);
                            const bool inw = (unsigned)(kci + kofs) < 16u;
                            s[sub][i] = inw ? s[sub][i] + bt[kci] : NEGBIG;
                        }
                }
                if constexpr (FAST) {
                    float ps0 = 0.f, ps1 = 0.f, ps2 = 0.f, ps3 = 0.f;
#pragma unroll
                    for (int sub = 0; sub < 2; ++sub)
#pragma unroll
                        for (int i = 0; i < 16; i += 4) {
                            const float p0 = __builtin_amdgcn_exp2f(s[sub][i]), p1 = __builtin_amdgcn_exp2f(s[sub][i + 1]);
                            const float p2 = __builtin_amdgcn_exp2f(s[sub][i + 2]), p3 = __builtin_amdgcn_exp2f(s[sub][i + 3]);
                            s[sub][i] = p0; s[sub][i + 1] = p1; s[sub][i + 2] = p2; s[sub][i + 3] = p3;
                            ps0 += p0; ps1 += p1; ps2 += p2; ps3 += p3;
                        }
                    l[mp] += (ps0 + ps1) + (ps2 + ps3);
                } else {
                float mx = s[0][0];
#pragma unroll
                for (int i = 1; i < 16; ++i) mx = fmaxf(mx, s[0][i]);
#pragma unroll
                for (int i = 0; i < 16; ++i) mx = fmaxf(mx, s[1][i]);
                mx = half_swap_max(mx);
                const float mnew = fmaxf(m[mp], mx);
                if (__any((mnew - m[mp]) > THR)) {
                    const float alpha = __builtin_amdgcn_exp2f(m[mp] - mnew);
#pragma unroll
                    for (int i = 0; i < 16; ++i) { o[mp][0][i] *= alpha; o[mp][1][i] *= alpha; }
                    l[mp] *= alpha;
                    m[mp] = mnew;
                }
                float ps = 0.f;
#pragma unroll
                for (int sub = 0; sub < 2; ++sub)
#pragma unroll
                    for (int i = 0; i < 16; ++i) { const float p = __builtin_amdgcn_exp2f(s[sub][i] - m[mp]); s[sub][i] = p; ps += p; }
                l[mp] += ps;
                }
#pragma unroll
                for (int sub = 0; sub < 2; ++sub)
#pragma unroll
                    for (int st = 0; st < 2; ++st) {
                        u32x4 pw = {pk2(s[sub][8 * st], s[sub][8 * st + 1]), pk2(s[sub][8 * st + 2], s[sub][8 * st + 3]),
                                    pk2(s[sub][8 * st + 4], s[sub][8 * st + 5]), pk2(s[sub][8 * st + 6], s[sub][8 * st + 7])};
                        pf[mp][sub][st] = __builtin_bit_cast(bf16x8, pw);
                    }
            }
#pragma unroll
            for (int st = 0; st < 2; ++st)
#pragma unroll
                for (int dvb = 0; dvb < 2; ++dvb) vfr[1][st][dvb] = vread(1, st, dvb);
#pragma unroll
            for (int sub = 0; sub < 2; ++sub)
#pragma unroll
                for (int st = 0; st < 2; ++st)
#pragma unroll
                    for (int dvb = 0; dvb < 2; ++dvb) {
#pragma unroll
                        for (int mp = 0; mp < NMAP; ++mp) o[mp][dvb] = __builtin_amdgcn_mfma_f32_32x32x16_bf16(vfr[sub][st][dvb], pf[mp][sub][st], o[mp][dvb], 0, 0, 0);
                    }
        }
    };
    load_tile(0, kregA, vregA);
    if (d.nt > 1) load_tile(1, kregB, vregB);
    store_tile(0, kregA, vregA);
    __syncthreads();
    if (pend != nullptr && tid == 0) (void)__hip_atomic_fetch_add(pend, 1u, __ATOMIC_RELAXED, __HIP_MEMORY_SCOPE_AGENT);
    for (int t = 0; t < d.nt; t += 2) {
        if (t + 2 < d.nt) load_tile(t + 2, kregA, vregA);
        tile_body(t, 0);
        if (t + 1 < d.nt) store_tile(1, kregB, vregB);
        __syncthreads();
        if (t + 1 < d.nt) {
            if (t + 3 < d.nt) load_tile(t + 3, kregB, vregB);
            tile_body(t + 1, 1);
            if (t + 2 < d.nt) store_tile(0, kregA, vregA);
            __syncthreads();
        }
    }
    int nxt_item = 0;
    if (qctr != nullptr && tid == 0) nxt_item = (int)atomicAdd(qctr, 1u);
    u32x4 zv4[4];
#pragma unroll
    for (int i = 0; i < 4; ++i) { const int idx = lane + 64 * i, row = idx >> 3, ch = idx & 7; zv4[i] = *(const u32x4*)(d.sz + (size_t)(w * 32 + row) * USTR + ch * 8); }
    float y[2][16];
    {
        float inv[NMAP];
#pragma unroll
        for (int mp = 0; mp < NMAP; ++mp) {
            const float lt = half_swap_sum(l[mp]);
            if (FAST) { if (__any(!(lt > 1e-30f && lt < 1e30f)) && lane == 0) *(LAS volatile unsigned*)(lds + LDS_CTLOFF + 32) = 1u; }
            inv[mp] = 1.f / lt;
        }
        if (MODE == 0) {
            float ss = 0.f;
#pragma unroll
            for (int dvb = 0; dvb < 2; ++dvb)
#pragma unroll
                for (int i = 0; i < 16; ++i) { const float v = o[0][dvb][i] * inv[0] - d.lam * (o[NMAP - 1][dvb][i] * inv[NMAP - 1]); y[dvb][i] = v; ss += v * v; }
            ss = half_swap_sum(ss);
            const float r = rsqrtf(ss * (1.f / 64.f) + eps_()) * d.oml;
#pragma unroll
            for (int dvb = 0; dvb < 2; ++dvb)
#pragma unroll
                for (int i = 0; i < 16; ++i) y[dvb][i] *= r * d.subg[dvb * 32 + crow(i, hh)];
        } else {
#pragma unroll
            for (int dvb = 0; dvb < 2; ++dvb)
#pragma unroll
                for (int i = 0; i < 16; ++i) y[dvb][i] = o[0][dvb][i] * inv[0];
        }
    }
    LAS bf16_t* stg = (LAS bf16_t*)(lds + w * 32 * 144);
#pragma unroll
    for (int dvb = 0; dvb < 2; ++dvb)
#pragma unroll
        for (int i = 0; i < 16; ++i) stg[r32 * 72 + dvb * 32 + crow(i, hh)] = (bf16_t)(pk2(y[dvb][i], 0.f) & 0xffffu);
    __builtin_amdgcn_s_waitcnt(0xc07f);
#pragma unroll
    for (int i = 0; i < 4; ++i) {
        const int idx = lane + 64 * i, row = idx >> 3, ch = idx & 7;
        const u32x4 ov = *(LAS const u32x4*)((LAS const unsigned char*)stg + row * 144 + ch * 16);
        const u32x4 zv = zv4[i];
        u32x4 rv;
#pragma unroll
        for (int j = 0; j < 4; ++j) {
            const float a0 = bf2f(ov[j] & 0xffffu) * bf2f(zv[j] & 0xffffu), a1 = bf2f(ov[j] >> 16) * bf2f(zv[j] >> 16);
            rv[j] = pk2(a0, a1);
        }
        asm volatile("global_store_dwordx4 %0, %1, off sc1\n\ts_nop 1" :: "v"(d.out + (size_t)(w * 32 + row) * DM + ch * 8), "v"(rv) : "memory");
    }
    if (qctr != nullptr && tid == 0) *(LAS volatile int*)(lds + LDS_CTLOFF + 16) = nxt_item;
    __syncthreads();
    if (FAST) return *(LAS volatile unsigned*)(lds + LDS_CTLOFF + 32) == 0u;
    return true;
}

DI void conv_item(const Params& P, int layer, int tile) {
    const bf16_t* U = (const bf16_t*)(P.ws + WS_U);
    bf16_t* YG = (bf16_t*)(P.ws + WS_YG);
    const float* cw = P.in[16] + layer * 3 * 256;
    const int tid = tidx(), ch = tid & 31, gA = tile * 256 + (tid >> 5) * 16;
    float w[3][8];
#pragma unroll
    for (int dd = 0; dd < 3; ++dd) {
        const f32x4 w0 = *(const f32x4*)(cw + dd * 256 + ch * 8), w1 = *(const f32x4*)(cw + dd * 256 + ch * 8 + 4);
#pragma unroll
        for (int j = 0; j < 4; ++j) { w[dd][j] = w0[j]; w[dd][4 + j] = w1[j]; }
    }
    const int L = (gA < NCTX) ? 256 : 2048;
    const int tposA = (gA < NCTX) ? (gA & 255) : ((gA - NCTX) & 2047);
    const bf16_t* ur = U + (size_t)gA * USTR + ch * 8;
    auto prod = [&](u32x4 bc, u32x4 bh, bool ok, float* pr) {
#pragma unroll
        for (int j = 0; j < 4; ++j) {
            pr[2 * j] = ok ? bf2f(bc[j] & 0xffffu) * bf2f(bh[j] & 0xffffu) : 0.f;
            pr[2 * j + 1] = ok ? bf2f(bc[j] >> 16) * bf2f(bh[j] >> 16) : 0.f;
        }
    };
    float pm[8], pc[8];
    {
        const bf16_t* r0 = ur - USTR;
        const u32x4 bcm = *(const u32x4*)(r0 + U_BC), bhm = *(const u32x4*)(r0 + U_BH), bc0 = *(const u32x4*)(ur + U_BC), bh0 = *(const u32x4*)(ur + U_BH);
        prod(bcm, bhm, tposA > 0, pm);
        prod(bc0, bh0, true, pc);
    }
#pragma unroll
    for (int bt = 0; bt < 2; ++bt) {
        u32x4 BC[8], BH[8], BB[8], ZZ[8];
#pragma unroll
        for (int q = 0; q < 8; ++q) {
            const bf16_t* rq = ur + (size_t)(bt * 8 + q) * USTR;
            BB[q] = *(const u32x4*)(rq + U_BB); ZZ[q] = *(const u32x4*)(rq + U_BZ);
            BC[q] = *(const u32x4*)(rq + USTR + U_BC); BH[q] = *(const u32x4*)(rq + USTR + U_BH);
        }
#pragma unroll
        for (int q = 0; q < 8; ++q) {
            const int i = bt * 8 + q;
            float pn[8];
            prod(BC[q], BH[q], tposA + i + 1 < L, pn);
            u32x4 rv;
#pragma unroll
            for (int j = 0; j < 4; ++j) {
                const float a0 = (pm[2 * j] * w[0][2 * j] + pc[2 * j] * w[1][2 * j] + pn[2 * j] * w[2][2 * j]) * bf2f(BB[q][j] & 0xffffu) * bf2f(ZZ[q][j] & 0xffffu);
                const float a1 = (pm[2 * j + 1] * w[0][2 * j + 1] + pc[2 * j + 1] * w[1][2 * j + 1] + pn[2 * j + 1] * w[2][2 * j + 1]) * bf2f(BB[q][j] >> 16) * bf2f(ZZ[q][j] >> 16);
                rv[j] = pk2(a0, a1);
            }
            asm volatile("global_store_dwordx4 %0, %1, off sc1\n\ts_nop 1" :: "v"(YG + (size_t)(gA + i) * DM + 256 + ch * 8), "v"(rv) : "memory");
#pragma unroll
            for (int j = 0; j < 8; ++j) { pm[j] = pc[j]; pc[j] = pn[j]; }
        }
    }
}

constexpr int P2_ATT = 384 + 192 + 48, P2_OUT = 192, P2_ITEMS = P2_ATT + P2_OUT;
DI int rstart(int r) { return min(max(r - 4, 0), 24); }

DI int phaseP2(const Params& P, LAS unsigned char* lds, int layer, int phase_id) {
    const bf16_t* U = (const bf16_t*)(P.ws + WS_U);
    const bf16_t* KC = (const bf16_t*)(P.ws + WS_KC);
    const bf16_t* KCC = (const bf16_t*)(P.ws + WS_KCC);
    const bf16_t* QC = (const bf16_t*)(P.ws + WS_QC);
    bf16_t* YG = (bf16_t*)(P.ws + WS_YG);
    unsigned* ctr = (unsigned*)(P.ws + WS_CTL) + CW_QUEUE + 64 * phase_id;
    LAS volatile int* sitem = (LAS volatile int*)(lds + LDS_CTLOFF + 16);
    const float* lamp = (const float*)(P.ws + WS_LAM) + layer * 2;
    unsigned* dep = (unsigned*)(P.ws + WS_CTL) + CW_DEP + 64 * (phase_id & 31);
    int first_tail = 0;
    unsigned* pend = nullptr;
    if (tidx() == 0) *sitem = (int)atomicAdd(ctr, 1u);
    for (;;) {
        __syncthreads();
        const int item = *sitem;
        __syncthreads();
        if (tidx() == 0) *(LAS volatile unsigned*)(lds + LDS_CTLOFF + 32) = 0u;
        if (item >= 576 && pend != nullptr) { dep_signal(pend); pend = nullptr; }
        if (item >= P2_ATT) { first_tail = item; break; }
        AttnDesc d;
        d.k1 = nullptr; d.v1 = nullptr; d.ks1 = 0; d.vs1 = 0; d.rpb = nullptr; d.qrow0 = 0; d.rs = 0; d.lam = 0.f; d.oml = 0.f; d.subg = nullptr;
        if (item >= 576) {
            int nx = 0;
            if (tidx() == 0) nx = (int)atomicAdd(ctr, 1u);
            conv_item(P, layer, item - 576);
            dep_signal(dep + (item - 576));
            if (tidx() == 0) *sitem = nx;
            continue;
        }
        int kind, panel;
        if (item < 384) {
            const int j = item & 127, b = j >> 5, h = (j >> 3) & 3, qb = j & 7;
            kind = item >> 7; panel = 16 + b * 8 + qb;
            const size_t tokb = NCTX + (size_t)b * 2048, tok0 = tokb + qb * 256;
            const size_t crow0 = (size_t)(b * 4 + layer) * 512;
            d.nt0 = 8; d.nt = 40;
            if (kind == 0) {
                d.q = U + tok0 * USTR + U_AQ + h * 64; d.qs = USTR;
                d.k0 = (const bf16_t*)(P.ws + WS_CAK) + crow0 * 256 + h * 64; d.v0 = (const bf16_t*)(P.ws + WS_CAV) + crow0 * 256 + h * 64; d.ks0 = 256; d.vs0 = 256;
                d.k1 = U + tokb * USTR + U_AK + h * 64; d.v1 = U + tokb * USTR + U_AV + h * 64; d.ks1 = USTR; d.vs1 = USTR;
                d.out = YG + tok0 * DM + h * 64; d.sz = U + tok0 * USTR + U_AZ + h * 64;
            } else if (kind == 1) {
                d.q = QC + tok0 * 384 + h * 96; d.qs = 384;
                d.k0 = KCC + ((size_t)(layer * 4 + b) * 512) * KCS + h * 160; d.v0 = d.k0 + 96; d.ks0 = KCS; d.vs0 = KCS;
                d.k1 = KC + tokb * KCS + h * 160; d.v1 = d.k1 + 96; d.ks1 = KCS; d.vs1 = KCS;
                d.out = YG + tok0 * DM + 512 + h * 64; d.sz = U + tok0 * USTR + U_CZ + h * 64;
            } else {
                const int r = 4 * qb, rs = rstart(r), nloc = rstart(r + 3) + 8 - rs;
                d.q = U + tok0 * USTR + U_DQ + h * 64; d.qs = USTR;
                d.k0 = (const bf16_t*)(P.ws + WS_CDK) + crow0 * 256 + h * 64; d.v0 = (const bf16_t*)(P.ws + WS_CDV) + crow0 * 256 + h * 64; d.ks0 = 256; d.vs0 = 256;
                d.k1 = U + (tokb + rs * 64) * USTR + U_DK + h * 64; d.v1 = U + (tokb + rs * 64) * USTR + U_DV + h * 64; d.ks1 = USTR; d.vs1 = USTR; d.nt = 8 + nloc;
                d.out = YG + tok0 * DM + 768 + h * 64; d.sz = U + tok0 * USTR + U_DZ + h * 64;
                d.rpb = P.in[21] + (size_t)(layer * 4 + h) * 15 * 31; d.qrow0 = r; d.rs = rs;
            }
        } else {
            const int jj = item - 384, j = jj & 63, b = j >> 2, h = j & 3;
            kind = jj >> 6; panel = b;
            const size_t tokb = (size_t)b * 256, tok0 = tokb;
            d.nt0 = 4; d.nt = 4;
            if (kind == 0) {
                d.q = U + tok0 * USTR + U_AQ + h * 64; d.qs = USTR;
                d.k0 = U + tokb * USTR + U_AK + h * 64; d.v0 = U + tokb * USTR + U_AV + h * 64; d.ks0 = USTR; d.vs0 = USTR;
                d.out = YG + tok0 * DM + h * 64; d.sz = U + tok0 * USTR + U_AZ + h * 64;
            } else if (kind == 1) {
                d.q = QC + tok0 * 384 + h * 96; d.qs = 384;
                d.k0 = KC + tokb * KCS + h * 160; d.v0 = d.k0 + 96; d.ks0 = KCS; d.vs0 = KCS;
                d.out = YG + tok0 * DM + 512 + h * 64; d.sz = U + tok0 * USTR + U_CZ + h * 64;
            } else {
                d.q = U + tok0 * USTR + U_DQ + h * 64; d.qs = USTR;
                d.k0 = U + tokb * USTR + U_DK + h * 64; d.v0 = U + tokb * USTR + U_DV + h * 64; d.ks0 = USTR; d.vs0 = USTR;
                d.out = YG + tok0 * DM + 768 + h * 64; d.sz = U + tok0 * USTR + U_DZ + h * 64;
            }
        }
        if (kind == 0) {
            d.lam = lamp[0]; d.oml = 1.f - lamp[1]; d.subg = P.in[15] + layer * 64;
            if (!attn_unit<0, true>(d, lds, ctr, pend)) attn_unit<0, false>(d, lds, nullptr, nullptr);
        } else if (kind == 1) { if (!attn_unit<1, true>(d, lds, ctr, pend)) attn_unit<1, false>(d, lds, nullptr, nullptr); }
        else { if (!attn_unit<2, true>(d, lds, ctr, pend)) attn_unit<2, false>(d, lds, nullptr, nullptr); }
        pend = dep + panel;
    }
    return first_tail;
}

DI void phaseP2_tail(LAS unsigned char* lds, int layer, int phase_id, int item) {
#ifdef __HIP_DEVICE_COMPILE__
    typedef __attribute__((address_space(4))) const Params* KArgPtr;
    KArgPtr pp_ = (KArgPtr)__builtin_amdgcn_kernarg_segment_ptr();
    asm volatile("" : "+s"(pp_));
    Params P;
    __builtin_memcpy(&P, pp_, sizeof(Params));
#else
    Params P{};
#endif
    unsigned* ctr = (unsigned*)(P.ws + WS_CTL) + CW_QUEUE + 64 * phase_id;
    unsigned* dep = (unsigned*)(P.ws + WS_CTL) + CW_DEP + 64 * (phase_id & 31);
    LAS volatile int* sitem = (LAS volatile int*)(lds + LDS_CTLOFF + 16);
    const int nitems = P2_ITEMS + (layer + 1 < DEPTH ? LP_TOTAL : 0);
    for (;;) {
        if (item >= nitems) break;
        if (item >= P2_ITEMS) {
            int nx = 0;
            if (tidx() == 0) nx = (int)atomicAdd(ctr, 1u);
            layer_prep_item(P, lds, layer + 1, item - P2_ITEMS);
            __syncthreads();
            if (tidx() == 0) *sitem = nx;
        } else {
            const int idx = item - P2_ATT, pmi = idx >> 2, pm = pmi < 32 ? 16 + pmi : pmi - 32;
            dep_wait(dep + pm, 13u);
            pg8::Gemm g{(const bf16_t*)(P.ws + WS_YG), (const bf16_t*)(P.ws + WS_WOUT) + (size_t)layer * 1024 * 1024, NTOK, 1024, 1024, 0};
            PQUnit S{pm, idx & 3};
            EpiP3G E{&P, layer};
            pg8::gemm_phase<EpiP3G, PQUnit, true, true>(lds, g, S, E);
            if (tidx() == 0) *sitem = (int)atomicAdd(ctr, 1u);
        }
        __syncthreads();
        item = *sitem;
        __syncthreads();
    }
}

DI void phaseP3(const Params& P, LAS unsigned char* lds, int layer, int phase_id) {
    pg8::Gemm g{(const bf16_t*)(P.ws + WS_YG), (const bf16_t*)(P.ws + WS_WOUT) + (size_t)layer * 1024 * 1024, NTOK, 1024, 1024, 0};
    pg8::StaticOrder S; S.init(NTOK, 1024, (int)gridDim.x, bidx());
    EpiP3G E{&P, layer};
    pg8::gemm_phase<EpiP3G, pg8::StaticOrder, true, true>(lds, g, S, E);
    pg8::Unit u;
    if (!S.next(0, u) && layer + 1 < DEPTH) {
        const int nidle = (int)gridDim.x - 192;
        for (int it = bidx() - 192; it < LP_TOTAL; it += nidle) layer_prep_item(P, lds, layer + 1, it);
    }
    if (FUSE_N && S.next(0, u)) {
        unsigned* cnt = (unsigned*)(P.ws + WS_CTL) + CW_DEP + 64 * phase_id + u.pm;
        dep_signal(cnt);
        dep_wait(cnt, 4u);
        const int r0 = u.pm * 256 + u.pn * 64;
        if (layer + 1 < DEPTH) phaseN_rows(P, layer + 1, r0, r0 + 64, 32);
        else phaseFinal_rows(P, r0, r0 + 64, 32);
    }
}

#define XB_TMO      128
#define XB_XCNT(j)  (256  + 64 * (j))
#define XB_XSUB(j)  (1280 + 64 * (j))
#define XB_XGEN(j)  (2304 + 64 * (j))
#define XB_TOP      3328
#define XB_TOPGEN   3392
#define XCD_BAR_WORDS 3456
#define XB_SPIN_CAP (1u << 18)
DI unsigned xb_ld(unsigned* p) { return __hip_atomic_load(p, __ATOMIC_RELAXED, __HIP_MEMORY_SCOPE_AGENT); }
DI unsigned xb_add(unsigned* p, unsigned v) { return __hip_atomic_fetch_add(p, v, __ATOMIC_RELAXED, __HIP_MEMORY_SCOPE_AGENT); }
DI unsigned xb_xcc_id() { return (unsigned)__builtin_amdgcn_s_getreg((3 << 11) | 20) & 0xFu; }
#define XB_SPIN(cond, bar) do { unsigned _sp = 0; while (cond) { __builtin_amdgcn_s_sleep(1); \
    if ((++_sp & 255u) == 0u) { if (xb_ld(&(bar)[XB_TMO])) break; if (_sp > XB_SPIN_CAP) { atomicAdd(&(bar)[XB_TMO], 1u); break; } } } } while (0)
struct XcdBarrier { unsigned* bar; unsigned x; volatile LAS unsigned* st; };
DI XcdBarrier xcd_barrier_post(unsigned* bar, volatile LAS unsigned* st) {
    XcdBarrier b; b.bar = bar; b.x = xb_xcc_id(); b.st = st;
    if (tidx() == 0) (void)xb_add(&bar[XB_XCNT(b.x)], 1u);
    return b;
}
DI void xcd_barrier_complete(unsigned* bar, unsigned x, unsigned& nloc, unsigned& nx) {
    const unsigned G = gridDim.x * gridDim.y * gridDim.z;
    unsigned sum, cnt, mine, sp = 0u;
    for (;;) {
        sum = 0u; cnt = 0u; mine = 0u;
#pragma unroll
        for (unsigned j = 0; j < 16; ++j) { const unsigned c = xb_ld(&bar[XB_XCNT(j)]); sum += c; cnt += (c > 0u) ? 1u : 0u; }
        if (sum == G) { mine = xb_ld(&bar[XB_XCNT(x)]); break; }
        __builtin_amdgcn_s_sleep(1);
        if ((++sp & 255u) == 0u) { if (xb_ld(&bar[XB_TMO])) break; if (sp > XB_SPIN_CAP) { atomicAdd(&bar[XB_TMO], 1u); break; } }
    }
    nloc = mine > 0u ? mine : 1u; nx = cnt > 0u ? cnt : 1u;
}
DI void xcd_barrier(const XcdBarrier& b) {
    asm volatile("s_waitcnt vmcnt(0)" ::: "memory");
    __syncthreads();
    if (tidx() == 0) {
        unsigned* bar = b.bar;
        __builtin_amdgcn_s_waitcnt(0);
        unsigned nloc = b.st[0], nx = b.st[1];
        if (nloc == 0u) { xcd_barrier_complete(bar, b.x, nloc, nx); b.st[0] = nloc; b.st[1] = nx; }
        const unsigned old = xb_add(&bar[XB_XSUB(b.x)], 1u);
        const unsigned gen = old / nloc;
        if (old + 1u == (gen + 1u) * nloc) {
            __builtin_amdgcn_fence(__ATOMIC_RELEASE, "agent");
            asm volatile("s_waitcnt vmcnt(0)" ::: "memory");
            const unsigned og = xb_add(&bar[XB_TOP], 1u);
            const unsigned tg = og / nx;
            if (og + 1u == (tg + 1u) * nx) xb_add(&bar[XB_TOPGEN], 1u);
            else XB_SPIN(xb_ld(&bar[XB_TOPGEN]) == tg, bar);
            __builtin_amdgcn_fence(__ATOMIC_ACQUIRE, "agent");
            xb_add(&bar[XB_XGEN(b.x)], 1u);
            asm volatile("s_waitcnt vmcnt(0)" ::: "memory");
        } else {
            XB_SPIN(xb_ld(&bar[XB_XGEN(b.x)]) == gen, bar);
            __builtin_amdgcn_fence(__ATOMIC_ACQUIRE, "agent");
            asm volatile("s_waitcnt vmcnt(0)" ::: "memory");
        }
    }
    __syncthreads();
}
constexpr int CW_BAR = 8192;

__global__ void __launch_bounds__(NT, 2) hybrid_fwd(Params P0_) {
    extern __shared__ __attribute__((aligned(16))) unsigned char smem[];
    LAS unsigned char* lds = (LAS unsigned char*)smem;
#if MEGA
    volatile LAS unsigned* xst = (volatile LAS unsigned*)(lds + LDS_CTLOFF);
    if (tidx() == 0) { xst[0] = 0u; xst[1] = 0u; }
    __syncthreads();
    const XcdBarrier xbar = xcd_barrier_post((unsigned*)(P0_.ws + WS_CTL) + CW_BAR, xst);
#endif
    for (int phc = P0_.ph_lo; phc < P0_.ph_hi; ++phc) {
        int ph = phc;
        asm volatile("" : "+s"(ph));
#ifdef __HIP_DEVICE_COMPILE__
        typedef __attribute__((address_space(4))) const Params* KArgPtr;
        KArgPtr pp_ = (KArgPtr)__builtin_amdgcn_kernarg_segment_ptr();
        asm volatile("" : "+s"(pp_));
        Params P;
        __builtin_memcpy(&P, pp_, sizeof(Params));
#else
        const Params P = P0_;
#endif
#ifdef REPEAT
        for (int rep = 0; rep < 2; ++rep) {
#else
        const int rep = 0;
        {
#endif
            bool again = false;
            if (ph == 0) {
                phase0(P, lds);
                dep_wait((unsigned*)(P.ws + WS_CTL) + CW_DEP, 48u);
                phaseN(P, 0);
            }
            else if (ph == 1) { }
            else {
                const int layer = (ph - 2) / 3, sub = (ph - 2) % 3;
                if (sub == 0) { phaseP1(P, lds, layer, ph); }
                else if (sub == 1) { const int ft = phaseP2(P, lds, layer, ph + 32 * rep); phaseP2_tail(lds, layer, ph + 32 * rep, ft); again = (REPEAT_MASK & 16) != 0; }
                else {
                    if (layer + 1 < DEPTH) phaseN(P, layer + 1); else phaseFinal_rows(P, bidx() * 32, NTOK, gridDim.x * 32);
                }
            }
#ifdef REPEAT
            if (!again || rep == 1) break;
            xcd_barrier(xbar);
#endif
        }
#if MEGA
        if (ph + 1 < P0_.ph_hi && ph != 1) xcd_barrier(xbar);
#ifdef DOUBLE_BAR
        if (ph + 1 < P0_.ph_hi) xcd_barrier(xbar);
#endif
#endif
    }
}

extern "C" void kernel_launch(void* const* d_in, const int* in_sizes, int n_in, void* d_out, int out_size, void* d_ws, size_t ws_size, hipStream_t stream) {
    static int grid_blocks = 0;
    if (grid_blocks == 0) {
        if (n_in != 24 || ws_size < WS_END) { fprintf(stderr, "kernel_launch: unexpected inputs (n_in %d, ws %zu)\n", n_in, ws_size); grid_blocks = -1; return; }
        int dev = 0, cus = 0, per_cu = 0;
        hipGetDevice(&dev);
        hipDeviceGetAttribute(&cus, hipDeviceAttributeMultiprocessorCount, dev);
        hipFuncSetAttribute((const void*)hybrid_fwd, hipFuncAttributeMaxDynamicSharedMemorySize, LDS_BYTES);
        hipOccupancyMaxActiveBlocksPerMultiprocessor(&per_cu, (const void*)hybrid_fwd, NT, LDS_BYTES);
        if (per_cu < 1) { fprintf(stderr, "kernel_launch: occupancy query says %d blocks per CU\n", per_cu); per_cu = 1; }
        if (per_cu > 1) per_cu = 1;
        grid_blocks = cus * per_cu;
        (void)hipGetLastError();
    }
    if (grid_blocks < 0) return;
    hipMemsetAsync((char*)d_ws + WS_CTL, 0, 65536, stream);
    Params p{};
    for (int i = 0; i < 24; ++i) p.in[i] = (const float*)d_in[i];
    p.out = (float*)d_out;
    p.ws = (unsigned char*)d_ws;
#if MEGA
    p.ph_lo = 0; p.ph_hi = NPHASE;
    void* args[] = {&p};
    hipError_t e = hipLaunchCooperativeKernel((const void*)hybrid_fwd, dim3(grid_blocks), dim3(NT), args, LDS_BYTES, stream);
    if (e != hipSuccess) fprintf(stderr, "cooperative launch failed: %s (grid %d)\n", hipGetErrorString(e), grid_blocks);
#else
    for (int ph = 0; ph < NPHASE; ++ph) {
        p.ph_lo = ph; p.ph_hi = ph + 1;
        hipLaunchKernelGGL(hybrid_fwd, dim3(grid_blocks), dim3(NT), LDS_BYTES, stream, p);
    }
#endif
}
```

```cpp
#include <hip/hip_runtime.h>
#include <hip/hip_cooperative_groups.h>
#include <stdint.h>
#include <stdio.h>
namespace cg = cooperative_groups;

#ifndef MEGA
#define MEGA 1
#endif
#ifndef FUSE_N
#define FUSE_N 0
#endif
#ifndef REPEAT_MASK
#define REPEAT_MASK 0
#endif

#define DI __device__ __forceinline__
#define LAS __attribute__((address_space(3)))
#define GAS __attribute__((address_space(1)))
typedef unsigned short bf16_t;
typedef short bf16x8 __attribute__((ext_vector_type(8)));
typedef short s16x4 __attribute__((ext_vector_type(4)));
typedef float f32x16 __attribute__((ext_vector_type(16)));
typedef float f32x4 __attribute__((ext_vector_type(4)));
typedef float f32x2 __attribute__((ext_vector_type(2)));
typedef unsigned u32x4 __attribute__((ext_vector_type(4)));
typedef unsigned u32x2 __attribute__((ext_vector_type(2)));
typedef __bf16 bf16v2 __attribute__((ext_vector_type(2)));

constexpr int DM = 1024, NCTX = 4096, NLAT = 8192, NTOK = 12288, DEPTH = 4;
constexpr int USTR = 3744;
constexpr int NPADW = 3840;
constexpr int U_AQ = 0, U_AK = 256, U_AV = 512, U_AZ = 768, U_BB = 1024, U_BC = 1280, U_BH = 1536, U_BZ = 1792,
              U_CQ = 2048, U_CKV = 2304, U_CZ = 2432, U_DQ = 2688, U_DK = 2944, U_DV = 3200, U_DZ = 3456, U_KPE = 3712;
constexpr int KCS = 640;
constexpr float LOG2E = 1.4426950408889634f, EPS = 1e-6f;
constexpr float SC_A = 0.17677669529663687f * LOG2E;
constexpr float SC_C = 0.10206207261596575f * LOG2E;
constexpr float SC_D = 0.125f * LOG2E;
constexpr float NEGBIG = -1e30f;

constexpr size_t O_YP = 0, O_YS = 4194304, O_SAK = 12582912, O_SAV = 16777216, O_SCKV = 20971520, O_SKPE = 23068672,
                 O_SDK = 23592960, O_SDV = 27787264;

constexpr size_t WS_CTL = 0;
constexpr size_t WS_MOD = 65536;
constexpr size_t WS_ROPE = WS_MOD + 4 * 5 * 3072 * 4;
constexpr size_t WS_LAM = WS_ROPE + 64 * 16 * 4;
constexpr size_t WS_SSQ = WS_LAM + 256;
constexpr size_t WS_WIN = WS_SSQ + (size_t)NTOK * 8 * 4;
constexpr size_t WS_WOUT = WS_WIN + (size_t)4 * NPADW * 1024 * 2;
constexpr size_t WS_WUQ = WS_WOUT + (size_t)4 * 1024 * 1024 * 2;
constexpr size_t WS_WUKV = WS_WUQ + (size_t)4 * 384 * 256 * 2;
constexpr size_t WS_CAK = WS_WUKV + (size_t)4 * 512 * 128 * 2;
constexpr size_t WS_CAV = WS_CAK + 4194304;
constexpr size_t WS_CDK = WS_CAV + 4194304;
constexpr size_t WS_CDV = WS_CDK + 4194304;
constexpr size_t WS_CKVC = WS_CDV + 4194304;
constexpr size_t WS_KCC = WS_CKVC + 2097152;
constexpr size_t WS_H = WS_KCC + (size_t)4 * 4 * 512 * KCS * 2;
constexpr size_t WS_U = WS_H + (size_t)NTOK * 1024 * 2;
constexpr size_t WS_KC = WS_U + (size_t)NTOK * USTR * 2;
constexpr size_t WS_QC = WS_KC + (size_t)NTOK * KCS * 2;
constexpr size_t WS_YG = WS_QC + (size_t)NTOK * 384 * 2;
constexpr size_t WS_XB = WS_YG + (size_t)NTOK * 1024 * 2;
constexpr size_t WS_END = WS_XB + (size_t)NTOK * 1024 * 2;
static_assert(WS_END <= (size_t)256 * 1024 * 1024, "workspace map exceeds 256 MiB");
static_assert(WS_WIN % 256 == 0 && WS_U % 256 == 0 && WS_KC % 256 == 0 && WS_QC % 256 == 0 && WS_YG % 256 == 0 && WS_H % 256 == 0, "align");

constexpr int NT = 512;
constexpr int CW_DEP = 4096;
constexpr int LDS_CTLOFF = 147456;
constexpr int LDS_BYTES = LDS_CTLOFF + 64;
constexpr int NPHASE = 14;
constexpr int CW_QUEUE = 64;

struct Params {
    const float* in[24];
    float* out;
    unsigned char* ws;
    int ph_lo, ph_hi;
};

DI int tidx() { int t = threadIdx.x; asm volatile("" : "+v"(t)); return t; }
DI int bidx() { int b = blockIdx.x; asm volatile("" : "+s"(b)); return b; }
DI float bf2f(unsigned b) { return __uint_as_float(b << 16); }
DI unsigned pk2(float lo, float hi) { f32x2 v = {lo, hi}; bf16v2 b = __builtin_convertvector(v, bf16v2); return __builtin_bit_cast(unsigned, b); }
DI float shx(float v, int mask) {
    const int lane = tidx() & 63;
    return __uint_as_float((unsigned)__builtin_amdgcn_ds_bpermute(((lane ^ mask) << 2), (int)__float_as_uint(v)));
}
DI float wave_sum(float v) {
#pragma unroll
    for (int o = 32; o >= 1; o >>= 1) v += shx(v, o);
    return v;
}
DI float half_swap_max(float v) {
    auto rr = __builtin_amdgcn_permlane32_swap(__float_as_uint(v), __float_as_uint(v), false, false);
    return fmaxf(__uint_as_float(rr[0]), __uint_as_float(rr[1]));
}
DI float half_swap_sum(float v) {
    auto rr = __builtin_amdgcn_permlane32_swap(__float_as_uint(v), __float_as_uint(v), false, false);
    return __uint_as_float(rr[0]) + __uint_as_float(rr[1]);
}
DI float eps_() { float e = EPS; asm volatile("" : "+v"(e)); return e; }
DI int crow(int i, int hh) { return (i & 3) + 8 * (i >> 2) + 4 * hh; }
DI float siluf(float x) { return x * __builtin_amdgcn_rcpf(1.f + __builtin_amdgcn_exp2f(x * -1.44269504f)); }
DI void store_bf16x32(bf16_t* dst, const float* v) {
#pragma unroll
    for (int q = 0; q < 4; ++q) {
        u32x4 w = {pk2(v[8 * q], v[8 * q + 1]), pk2(v[8 * q + 2], v[8 * q + 3]), pk2(v[8 * q + 4], v[8 * q + 5]), pk2(v[8 * q + 6], v[8 * q + 7])};
        *(u32x4*)(dst + 8 * q) = w;
    }
}
DI void store_f32x32(float* dst, const float* v) {
#pragma unroll
    for (int q = 0; q < 8; ++q) { f32x4 w = {v[4 * q], v[4 * q + 1], v[4 * q + 2], v[4 * q + 3]}; *(f32x4*)(dst + 4 * q) = w; }
}
DI void rope32(float* v, const float* rope, int t) {
    const float* tr = rope + (t >> 6) * 16;
    const float* tc = rope + (t & 63) * 16;
#pragma unroll
    for (int a = 0; a < 2; ++a) {
        const float* tb = a ? tc : tr;
#pragma unroll
        for (int i = 0; i < 8; ++i) {
            const float c = tb[i], s = tb[8 + i];
            const float x0 = v[a * 16 + i], x1 = v[a * 16 + 8 + i];
            v[a * 16 + i] = x0 * c - x1 * s;
            v[a * 16 + 8 + i] = x1 * c + x0 * s;
        }
    }
}

template <int BM, class AF>
DI void gemm_mainloop(LAS unsigned char* lds, const AF& af, int m0, const bf16_t* __restrict__ Bt, int ldb, int n0, int K, f32x16 (&acc)[BM / 128][2]) {
    constexpr int NA = BM * 8 / NT, NB = 128 * 8 / NT, MI = BM / 128;
    constexpr int STAGE = (BM + 128) * 128;
    const int tid = tidx(), lane = tid & 63, r32 = lane & 31, hh = lane >> 5;
    const int w = __builtin_amdgcn_readfirstlane(tid >> 6), wr = w >> 1, wc = w & 1;
    const bf16_t* ap[NA];
    const bf16_t* bp[NB];
#pragma unroll
    for (int i = 0; i < NA; ++i) { const int p = tid + NT * i, row = p >> 3, cs = (p & 7) ^ ((row >> 1) & 7); ap[i] = af.row(m0 + row) + cs * 8; }
#pragma unroll
    for (int i = 0; i < NB; ++i) { const int p = tid + NT * i, row = p >> 3, cs = (p & 7) ^ ((row >> 1) & 7); bp[i] = Bt + (size_t)(n0 + row) * ldb + cs * 8; }
#pragma unroll
    for (int mi = 0; mi < MI; ++mi)
#pragma unroll
        for (int ni = 0; ni < 2; ++ni)
#pragma unroll
            for (int i = 0; i < 16; ++i) acc[mi][ni][i] = 0.f;
    const int nk = K / 64;
    const int xr = (r32 >> 1) & 7;
    const int arow = (wr * (BM / 4) + r32) * 128, brow = (wc * 64 + r32) * 128;
    auto stage = [&](int s, int kt) {
        LAS unsigned char* sa = lds + s * STAGE;
        LAS unsigned char* sb = sa + BM * 128;
#pragma unroll
        for (int i = 0; i < NA; ++i)
            __builtin_amdgcn_global_load_lds((const GAS void*)(ap[i] + kt * 64), (LAS void*)(sa + (w * 64 + NT * i) * 16), 16, 0, 0);
#pragma unroll
        for (int i = 0; i < NB; ++i)
            __builtin_amdgcn_global_load_lds((const GAS void*)(bp[i] + kt * 64), (LAS void*)(sb + (w * 64 + NT * i) * 16), 16, 0, 0);
    };
    stage(0, 0);
    for (int kt = 0; kt < nk; ++kt) {
        asm volatile("s_waitcnt vmcnt(0)" ::: "memory");
        __syncthreads();
        if (kt + 1 < nk) stage((kt + 1) & 1, kt + 1);
        LAS const unsigned char* sa = lds + (kt & 1) * STAGE;
        LAS const unsigned char* sb = sa + BM * 128;
#pragma unroll
        for (int kk = 0; kk < 4; ++kk) {
            const int co = (((kk * 2 + hh) ^ xr) << 4);
            bf16x8 a[MI], b[2];
#pragma unroll
            for (int mi = 0; mi < MI; ++mi) a[mi] = *(LAS const bf16x8*)(sa + arow + mi * 32 * 128 + co);
#pragma unroll
            for (int ni = 0; ni < 2; ++ni) b[ni] = *(LAS const bf16x8*)(sb + brow + ni * 32 * 128 + co);
#pragma unroll
            for (int mi = 0; mi < MI; ++mi)
#pragma unroll
                for (int ni = 0; ni < 2; ++ni) acc[mi][ni] = __builtin_amdgcn_mfma_f32_32x32x16_bf16(a[mi], b[ni], acc[mi][ni], 0, 0, 0);
        }
    }
    __syncthreads();
}

template <class EPI>
DI void staged_epilogue(LAS unsigned char* lds, f32x16 (&acc)[2][2], int m0, int n0, const EPI& epi) {
    const int tid = tidx(), lane = tid & 63, r32 = lane & 31, hh = lane >> 5;
    const int w = __builtin_amdgcn_readfirstlane(tid >> 6), wr = w >> 1, wc = w & 1;
    LAS float* st = (LAS float*)lds;
#pragma unroll
    for (int half = 0; half < 2; ++half) {
        if ((wr >> 1) == half) {
#pragma unroll
            for (int mi = 0; mi < 2; ++mi)
#pragma unroll
                for (int ni = 0; ni < 2; ++ni)
#pragma unroll
                    for (int i = 0; i < 16; ++i) st[((wr & 1) * 64 + mi * 32 + crow(i, hh)) * 132 + wc * 64 + ni * 32 + r32] = acc[mi][ni][i];
        }
        __syncthreads();
        {
            const int row = tid >> 2, ch = tid & 3;
            float v[32];
#pragma unroll
            for (int q = 0; q < 8; ++q) {
                const f32x4 t = *(LAS const f32x4*)(st + row * 132 + ch * 32 + q * 4);
                v[4 * q] = t[0]; v[4 * q + 1] = t[1]; v[4 * q + 2] = t[2]; v[4 * q + 3] = t[3];
            }
            epi(m0 + half * 128 + row, (n0 >> 5) + ch, v);
        }
        __syncthreads();
    }
}

DI void p0_mod_item(const Params& P, LAS unsigned char* lds, int item) {
    const int l = item / 48, n0 = (item % 48) * 64, tid = tidx();
    LAS float* sc = (LAS float*)lds;
    LAS float* red = sc + 5 * 1024;
    const float* c = P.in[8];
    const float* cctx = P.in[9];
    for (int idx = tid; idx < 5 * 1024; idx += NT) {
        const int j = idx >> 10, k = idx & 1023;
        const float x = (j == 0) ? cctx[k] : c[(j - 1) * 1024 + k];
        sc[idx] = x / (1.f + expf(-x));
    }
    __syncthreads();
    const int c4 = (tid & 15) * 4, kg = tid >> 4;
    const float* wp = P.in[10] + (size_t)l * 1024 * 3072 + (size_t)(kg * 32) * 3072 + n0 + c4;
    f32x4 a0 = {0.f, 0.f, 0.f, 0.f}, a1 = a0, a2 = a0, a3 = a0, a4 = a0;
#pragma unroll
    for (int h = 0; h < 2; ++h) {
        f32x4 w[16];
#pragma unroll
        for (int k = 0; k < 16; ++k) w[k] = *(const f32x4*)(wp + (size_t)(h * 16 + k) * 3072);
#pragma unroll
        for (int k = 0; k < 16; ++k) {
            const int kk = kg * 32 + h * 16 + k;
            a0 += sc[kk] * w[k]; a1 += sc[1024 + kk] * w[k]; a2 += sc[2048 + kk] * w[k]; a3 += sc[3072 + kk] * w[k]; a4 += sc[4096 + kk] * w[k];
        }
    }
    *(LAS f32x4*)(red + (kg * 5 + 0) * 64 + c4) = a0; *(LAS f32x4*)(red + (kg * 5 + 1) * 64 + c4) = a1; *(LAS f32x4*)(red + (kg * 5 + 2) * 64 + c4) = a2;
    *(LAS f32x4*)(red + (kg * 5 + 3) * 64 + c4) = a3; *(LAS f32x4*)(red + (kg * 5 + 4) * 64 + c4) = a4;
    __syncthreads();
    float* mod = (float*)(P.ws + WS_MOD);
    for (int idx = tid; idx < 320; idx += NT) {
        const int j = idx >> 6, cc = idx & 63;
        float s = P.in[11][l * 3072 + n0 + cc];
#pragma unroll 8
        for (int g = 0; g < 32; ++g) s += red[(g * 5 + j) * 64 + cc];
        mod[(l * 5 + j) * 3072 + n0 + cc] = s;
    }
    asm volatile("s_waitcnt vmcnt(0)" ::: "memory");
    __syncthreads();
    if (l == 0 && tid == 0) {
        __builtin_amdgcn_fence(__ATOMIC_RELEASE, "agent");
        asm volatile("s_waitcnt vmcnt(0)" ::: "memory");
        (void)__hip_atomic_fetch_add((unsigned*)(P.ws + WS_CTL) + CW_DEP, 1u, __ATOMIC_RELAXED, __HIP_MEMORY_SCOPE_AGENT);
    }
}

DI void p0_transpose_item(LAS unsigned char* lds, const float* src, int N, int k0, int ns0, int nvalid, bf16_t* dst, int ldd, int nd0, const float* kscale) {
    LAS float* T = (LAS float*)lds;
    const int tid = tidx();
#pragma unroll
    for (int i = 0; i < 2; ++i) {
        const int idx = tid + NT * i, kk = idx >> 4, n4 = (idx & 15) * 4;
        f32x4 v = {0.f, 0.f, 0.f, 0.f};
        if (n4 < nvalid) v = *(const f32x4*)(src + (size_t)(k0 + kk) * N + ns0 + n4);
        const float s = kscale ? kscale[k0 + kk] : 1.f;
        T[kk * 65 + n4] = v[0] * s; T[kk * 65 + n4 + 1] = v[1] * s; T[kk * 65 + n4 + 2] = v[2] * s; T[kk * 65 + n4 + 3] = v[3] * s;
    }
    __syncthreads();
    {
        const int idx = tid, nn = idx >> 3, kc = idx & 7;
        float v[8];
#pragma unroll
        for (int j = 0; j < 8; ++j) v[j] = T[(kc * 8 + j) * 65 + nn];
        u32x4 wv = {pk2(v[0], v[1]), pk2(v[2], v[3]), pk2(v[4], v[5]), pk2(v[6], v[7])};
        *(u32x4*)(dst + (size_t)(nd0 + nn) * ldd + k0 + kc * 8) = wv;
    }
    __syncthreads();
}

DI void p0_transpose_batch4(LAS unsigned char* lds, const float* src, int N, int k0, int jt0, int jmax, bool win, bf16_t* dst, int ldd) {
    LAS float* T = (LAS float*)lds;
    const int tid = tidx();
    f32x4 v[4][2];
#pragma unroll
    for (int q = 0; q < 4; ++q) {
        const int j = jt0 + q;
        const int ns0 = !win ? 64 * j : (j < 38) ? 64 * j : (j < 58 ? 64 * j + 32 : 2432), nvalid = (win && j == 58) ? 32 : 64;
#pragma unroll
        for (int i = 0; i < 2; ++i) {
            const int idx = tid + NT * i, kk = idx >> 4, n4 = (idx & 15) * 4;
            v[q][i] = (f32x4){0.f, 0.f, 0.f, 0.f};
            if (j < jmax && n4 < nvalid) v[q][i] = *(const f32x4*)(src + (size_t)(k0 + kk) * N + ns0 + n4);
        }
    }
#pragma unroll
    for (int q = 0; q < 4; ++q)
#pragma unroll
        for (int i = 0; i < 2; ++i) {
            const int idx = tid + NT * i, kk = idx >> 4, n4 = (idx & 15) * 4;
            LAS float* Tq = T + q * 64 * 65;
            Tq[kk * 65 + n4] = v[q][i][0]; Tq[kk * 65 + n4 + 1] = v[q][i][1]; Tq[kk * 65 + n4 + 2] = v[q][i][2]; Tq[kk * 65 + n4 + 3] = v[q][i][3];
        }
    __syncthreads();
#pragma unroll
    for (int q = 0; q < 4; ++q) {
        if (jt0 + q < jmax) {
            const int nn = tid >> 3, kc = tid & 7;
            LAS const float* Tq = T + q * 64 * 65;
            float w[8];
#pragma unroll
            for (int j = 0; j < 8; ++j) w[j] = Tq[(kc * 8 + j) * 65 + nn];
            u32x4 wv = {pk2(w[0], w[1]), pk2(w[2], w[3]), pk2(w[4], w[5]), pk2(w[6], w[7])};
            *(u32x4*)(dst + (size_t)((jt0 + q) * 64 + nn) * ldd + k0 + kc * 8) = wv;
        }
    }
    __syncthreads();
}

DI void p0_convert_flat(const float* src, bf16_t* dst, int item) {
    const size_t e = (size_t)item * 4096 + tidx() * 8;
    const f32x4 a = *(const f32x4*)(src + e), b = *(const f32x4*)(src + e + 4);
    u32x4 wv = {pk2(a[0], a[1]), pk2(a[2], a[3]), pk2(b[0], b[1]), pk2(b[2], b[3])};
    *(u32x4*)(dst + e) = wv;
}

DI void win_copy_item(const Params& P, LAS unsigned char* lds, int l, int r) {
    const int kt = r / 15, jb = r % 15;
    p0_transpose_batch4(lds, P.in[13] + (size_t)l * 1024 * 3744, 3744, kt * 64, jb * 4, 59, true, (bf16_t*)(P.ws + WS_WIN) + (size_t)l * NPADW * 1024, 1024);
}
DI void p0_convert_flat4(const float* src, bf16_t* dst) {
    const size_t e0 = (size_t)tidx() * 8;
    f32x4 a[4], b[4];
#pragma unroll
    for (int q = 0; q < 4; ++q) { a[q] = *(const f32x4*)(src + e0 + q * 4096); b[q] = *(const f32x4*)(src + e0 + q * 4096 + 4); }
#pragma unroll
    for (int q = 0; q < 4; ++q) {
        u32x4 wv = {pk2(a[q][0], a[q][1]), pk2(a[q][2], a[q][3]), pk2(b[q][0], b[q][1]), pk2(b[q][2], b[q][3])};
        *(u32x4*)(dst + e0 + q * 4096) = wv;
    }
}
constexpr int LP_WIN = 240, LP_WOUT = 64, LP_CA = 32, LP_CKV = 16, LP_KPE = 16, LP_TOTAL = LP_WIN + LP_WOUT + 4 * LP_CA + LP_CKV + LP_KPE;
DI void layer_prep_item(const Params& P, LAS unsigned char* lds, int l, int it) {
    if (it < LP_WIN) { win_copy_item(P, lds, l, it); return; }
    it -= LP_WIN;
    if (it < LP_WOUT) {
        const int kt = it >> 2, jb = it & 3;
        p0_transpose_batch4(lds, P.in[22] + (size_t)l * 1024 * 1024, 1024, kt * 64, jb * 4, 16, false, (bf16_t*)(P.ws + WS_WOUT) + (size_t)l * 1024 * 1024, 1024);
        return;
    }
    it -= LP_WOUT;
    if (it < 4 * LP_CA) {
        const int which = it >> 5, r = it & 31, b = r >> 3, sub = r & 7;
        const size_t off = (size_t)(b * 4 + l) * 131072 + (size_t)sub * 16384;
        if (which == 0) p0_convert_flat4(P.in[2] + off, (bf16_t*)(P.ws + WS_CAK) + off);
        else if (which == 1) p0_convert_flat4(P.in[3] + off, (bf16_t*)(P.ws + WS_CAV) + off);
        else if (which == 2) p0_convert_flat4(P.in[6] + off, (bf16_t*)(P.ws + WS_CDK) + off);
        else p0_convert_flat4(P.in[7] + off, (bf16_t*)(P.ws + WS_CDV) + off);
        return;
    }
    it -= 4 * LP_CA;
    if (it < LP_CKV) {
        const int b = it >> 2, sub = it & 3;
        const size_t off = (size_t)(b * 4 + l) * 65536 + (size_t)sub * 16384;
        p0_convert_flat4(P.in[4] + off, (bf16_t*)(P.ws + WS_CKVC) + off);
        return;
    }
    it -= LP_CKV;
    {
        const int b = it >> 2, sub = it & 3;
        const size_t e = (size_t)sub * 4096 + tidx() * 8;
        const float* src = P.in[5] + (size_t)(b * 4 + l) * 16384 + e;
        const f32x4 a = *(const f32x4*)(src), bq = *(const f32x4*)(src + 4);
        u32x4 wv = {pk2(a[0], a[1]), pk2(a[2], a[3]), pk2(bq[0], bq[1]), pk2(bq[2], bq[3])};
        const int j0 = (int)(e & 31), t = (int)(e >> 5);
        bf16_t* dst = (bf16_t*)(P.ws + WS_KCC) + ((size_t)(l * 4 + b) * 512 + t) * KCS + 64 + j0;
#pragma unroll
        for (int h = 0; h < 4; ++h) *(u32x4*)(dst + h * 160) = wv;
    }
}
constexpr int P0_MOD = 192, P0_WIN = 16 * 15  , P0_WOUT = 4 * 16 * 4, P0_WUQ = 4 * 4 * 6, P0_WUKV = 4 * 2 * 8,
              P0_CA = 512, P0_CKV = 256, P0_KPE = 64, P0_MISC = 1;
constexpr int P0_TOTAL = P0_MOD + P0_WIN + P0_WOUT + P0_WUQ + P0_WUKV + 4 * P0_CA + P0_CKV + P0_KPE + P0_MISC;

DI void phase0(const Params& P, LAS unsigned char* lds) {
    constexpr int P0_ALL = P0_MOD + LP_TOTAL + P0_WUQ + P0_WUKV + 1;
    for (int it = bidx(); it < P0_ALL; it += gridDim.x) {
        int item = it;
        if (item < P0_MOD) { p0_mod_item(P, lds, item); continue; }
        item -= P0_MOD;
        if (item < LP_TOTAL) { layer_prep_item(P, lds, 0, item); continue; }
        item -= LP_TOTAL;
        if (item < P0_WUQ) {
            const int l = item / 24, r = item % 24, kt = r / 6, j = r % 6;
            p0_transpose_item(lds, P.in[18] + (size_t)l * 256 * 384, 384, kt * 64, j * 64, 64, (bf16_t*)(P.ws + WS_WUQ) + (size_t)l * 384 * 256, 256, j * 64, P.in[17] + l * 256);
            continue;
        }
        item -= P0_WUQ;
        if (item < P0_WUKV) {
            const int l = item >> 4, r = item & 15, kt = r >> 3, j = r & 7;
            p0_transpose_item(lds, P.in[20] + (size_t)l * 128 * 512, 512, kt * 64, j * 64, 64, (bf16_t*)(P.ws + WS_WUKV) + (size_t)l * 512 * 128, 128, j * 64, nullptr);
            continue;
        }
        {
            const int tid = tidx();
            float* rope = (float*)(P.ws + WS_ROPE);
            for (int idx = tid; idx < 512; idx += NT) {
                const int pos = idx >> 3, i = idx & 7;
                const float inv = 1.0f / powf(10000.f, (float)(2 * i) / 16.f);
                const float ang = (float)pos * inv;
                rope[pos * 16 + i] = cosf(ang);
                rope[pos * 16 + 8 + i] = sinf(ang);
            }
            if (tid < 4) {
                const float* lv = P.in[14] + tid * 128;
                float s1 = 0.f, s2 = 0.f;
                for (int d = 0; d < 32; ++d) { s1 += lv[d] * lv[32 + d]; s2 += lv[64 + d] * lv[96 + d]; }
                const float li = 0.8f - 0.6f * expf(-0.3f * (float)tid);
                float* lam = (float*)(P.ws + WS_LAM);
                lam[tid * 2] = expf(s1) - expf(s2) + li;
                lam[tid * 2 + 1] = li;
            }
        }
    }
}

DI const float* xrow_ptr(const Params& P, int layer, int row) {
    if (layer == 0) return (row < NCTX) ? P.in[0] + (size_t)row * DM : P.in[1] + (size_t)(row - NCTX) * DM;
    return P.out + (size_t)row * DM;
}
DI void phaseN_rows(const Params& P, int layer, int row0, int rend, int rstep) {
    const int lane = tidx() & 63, w = tidx() >> 6;
    const float* g = P.in[12] + layer * DM;
    bf16_t* H = (bf16_t*)(P.ws + WS_H);
    for (int rb = row0; rb < rend; rb += rstep) {
        const int mi = (rb < NCTX) ? 0 : 1 + ((rb - NCTX) >> 11);
        const float* mod = (const float*)(P.ws + WS_MOD) + (size_t)(layer * 5 + mi) * 3072;
        f32x4 ca[4], cb[4];
#pragma unroll
        for (int i = 0; i < 4; ++i) {
            const int n = lane * 4 + 256 * i;
            const f32x4 gg = *(const f32x4*)(g + n), sc = *(const f32x4*)(mod + 1024 + n);
            cb[i] = *(const f32x4*)(mod + n);
            ca[i] = gg * (1.f + sc);
        }
        const int r4 = rb + 4 * w;
        f32x4 v[4][4];
        if (layer == 0) {
#pragma unroll
            for (int q = 0; q < 4; ++q) {
                const float* x = xrow_ptr(P, 0, r4 + q);
#pragma unroll
                for (int i = 0; i < 4; ++i) v[q][i] = *(const f32x4*)(x + lane * 4 + 256 * i);
            }
        } else {
            u32x2 xv[4][4];
#pragma unroll
            for (int q = 0; q < 4; ++q) {
                const bf16_t* x = (const bf16_t*)(P.ws + WS_XB) + (size_t)(r4 + q) * DM;
#pragma unroll
                for (int i = 0; i < 4; ++i) xv[q][i] = *(const u32x2*)(x + lane * 4 + 256 * i);
            }
#pragma unroll
            for (int q = 0; q < 4; ++q)
#pragma unroll
                for (int i = 0; i < 4; ++i) v[q][i] = (f32x4){bf2f(xv[q][i][0] & 0xffffu), bf2f(xv[q][i][0] >> 16), bf2f(xv[q][i][1] & 0xffffu), bf2f(xv[q][i][1] >> 16)};
        }
        float ss[4];
#pragma unroll
        for (int q = 0; q < 4; ++q) {
            float a = 0.f;
#pragma unroll
            for (int i = 0; i < 4; ++i) a += v[q][i][0] * v[q][i][0] + v[q][i][1] * v[q][i][1] + v[q][i][2] * v[q][i][2] + v[q][i][3] * v[q][i][3];
            ss[q] = a;
        }
#pragma unroll
        for (int o = 32; o >= 1; o >>= 1) {
#pragma unroll
            for (int q = 0; q < 4; ++q) ss[q] += shx(ss[q], o);
        }
#pragma unroll
        for (int q = 0; q < 4; ++q) {
            const float r = rsqrtf(ss[q] * (1.f / 1024.f) + eps_());
#pragma unroll
            for (int i = 0; i < 4; ++i) {
                const f32x4 o = v[q][i] * r * ca[i] + cb[i];
                u32x2 wv = {pk2(o[0], o[1]), pk2(o[2], o[3])};
                *(u32x2*)(H + (size_t)(r4 + q) * DM + lane * 4 + 256 * i) = wv;
            }
        }
    }
}
DI void phaseN(const Params& P, int layer) { phaseN_rows(P, layer, bidx() * 32, NTOK, gridDim.x * 32); }
DI void phaseFinal_rows(const Params& P, int row0, int rend, int rstep) {
    const int lane = tidx() & 63, w = tidx() >> 6;
    const float* g = P.in[23];
    f32x4 cg[4];
#pragma unroll
    for (int i = 0; i < 4; ++i) cg[i] = *(const f32x4*)(g + lane * 4 + 256 * i);
    for (int rb = row0; rb < rend; rb += rstep) {
        const int r4 = rb + 4 * w;
        f32x4 v[4][4];
#pragma unroll
        for (int q = 0; q < 4; ++q) {
            const bf16_t* x = (const bf16_t*)(P.ws + WS_XB) + (size_t)(r4 + q) * DM;
#pragma unroll
            for (int i = 0; i < 4; ++i) {
                const u32x2 xv = *(const u32x2*)(x + lane * 4 + 256 * i);
                v[q][i] = (f32x4){bf2f(xv[0] & 0xffffu), bf2f(xv[0] >> 16), bf2f(xv[1] & 0xffffu), bf2f(xv[1] >> 16)};
            }
        }
        float ss[4];
#pragma unroll
        for (int q = 0; q < 4; ++q) {
            float a = 0.f;
#pragma unroll
            for (int i = 0; i < 4; ++i) a += v[q][i][0] * v[q][i][0] + v[q][i][1] * v[q][i][1] + v[q][i][2] * v[q][i][2] + v[q][i][3] * v[q][i][3];
            ss[q] = a;
        }
#pragma unroll
        for (int o = 32; o >= 1; o >>= 1) {
#pragma unroll
            for (int q = 0; q < 4; ++q) ss[q] += shx(ss[q], o);
        }
#pragma unroll
        for (int q = 0; q < 4; ++q) {
            const float r = rsqrtf(ss[q] * (1.f / 1024.f) + eps_());
#pragma unroll
            for (int i = 0; i < 4; ++i) *(f32x4*)(P.out + (size_t)(r4 + q) * DM + lane * 4 + 256 * i) = v[q][i] * r * cg[i];
        }
    }
}

namespace pg8 {
#define PG8_LAS __attribute__((address_space(3)))
typedef unsigned short bf16_t;
typedef short bf16x8 __attribute__((ext_vector_type(8)));
typedef float f32x4 __attribute__((ext_vector_type(4)));
typedef unsigned u32x4 __attribute__((ext_vector_type(4)));
constexpr int BM = 256, BK = 64, HALF = 128, HTB = HALF * BK * 2  , STAGE_BYTES = 8 * HTB, NXCD = 8, WGM = 8;

__host__ __device__ __forceinline__ int lds_byte(int r, int c) { const int st = (r >> 4) * 2 + (c >> 5), rr = r & 15, cc = c & 31, ob = rr * 64 + cc * 2; return st * 1024 + (ob ^ (((ob >> 9) & 1) << 5)); }
__host__ __device__ __forceinline__ void stage_rc(int b, int& R, int& C) { const int st = b / 1024, sb = b % 1024, swz = sb ^ (((sb >> 9) & 1) << 5); R = (st >> 1) * 16 + swz / 64; C = (st & 1) * 32 + (swz % 64) / 2; }
__host__ __device__ __forceinline__ int perm32(int rho) { const int n = rho >> 4, i = rho & 15; return 8 * (i >> 2) + 4 * n + (i & 3); }

struct Unit { int pm, pn; };
struct Gemm { const bf16_t* A; const bf16_t* Bt; int M, N, K; int lda; };

struct StaticOrder {
    int nM, nN, nwg, G, c;
    __host__ __device__ void init(int M, int N, int G_, int c_) { nM = M / BM; nN = N / BM; nwg = nM * nN; G = G_; c = c_; }
    __host__ __device__ bool next(int i, Unit& u) const {
        const long L = (long)i * G + c; if (L >= nwg) return false;
        int wgid = (int)L; { const int q = nwg / NXCD, r = nwg % NXCD, xcd = wgid % NXCD, off = wgid / NXCD; wgid = (xcd < r ? xcd * (q + 1) : r * (q + 1) + (xcd - r) * q) + off; }
        const int nig = WGM * nN, gid = wgid / nig, fm = gid * WGM, gsz = (nM - fm) < WGM ? (nM - fm) : WGM;
        u.pm = fm + ((wgid % nig) % gsz); u.pn = (wgid % nig) / gsz; return true;
    }
    __device__ __forceinline__ void a_ready(const Unit&) const {}
    __device__ __forceinline__ void done(const Unit&) const {}
};

template <class Epi, class Sched, bool ALIGN_EPI = false, bool SP2 = false>
__device__ __forceinline__ void gemm_phase(PG8_LAS unsigned char* lds, const Gemm g, const Sched& S, const Epi& E) {
    const int tid = tidx(), wid = __builtin_amdgcn_readfirstlane(tid >> 6), lane = tid & 63, wr = wid >> 2, wc = wid & 3, fr = lane & 15, fq = lane >> 4;
    const int K = g.K, nt = K / BK, LDA = g.lda ? g.lda : g.K;
    unsigned voffA[2], voffB[2];
#pragma unroll
    for (int i = 0; i < 2; ++i) { int R, C; stage_rc(tid * 16 + i * 8192, R, C); const int Rb = Epi::PERM ? ((R & ~31) + perm32(R & 31)) : R;
        voffA[i] = (unsigned)(R * LDA + C) * 2u; voffB[i] = (unsigned)(Rb * K + C) * 2u; }
    const size_t kstep = (size_t)(BK * 2);
    const size_t hstepB = (size_t)HALF * K * 2, hstepA = (size_t)HALF * LDA * 2;
    const size_t tstepB = 2 * hstepB, tstepA = 2 * hstepA;
    const unsigned ldsw = (unsigned)wid * 1024u;
    const int aoff = lds_byte(wr * 64 + fr, fq * 8), boff = lds_byte(wc * 32 + fr, fq * 8);
#define PG8_SA(b, h) (((b) * 2 + (h)) * HTB)
#define PG8_SB(b, h) ((4 + (b) * 2 + (h)) * HTB)
#define PG8_STAGE(bufoff, gbase, voff) do { _Pragma("unroll") for (int _i = 0; _i < 2; ++_i) \
        __builtin_amdgcn_global_load_lds((const unsigned*)((const char*)(gbase) + (voff)[_i]), (PG8_LAS unsigned*)(lds + (bufoff) + ldsw + _i * 8192), 16, 0, 0); } while (0)
#define PG8_LDA(dst, b, h) do { _Pragma("unroll") for (int m = 0; m < 4; ++m) _Pragma("unroll") for (int k = 0; k < 2; ++k) dst[m][k] = *(const PG8_LAS bf16x8*)(lds + PG8_SA(b, h) + aoff + m * 2048 + k * 1024); } while (0)
#define PG8_LDB(dst, b, h) do { _Pragma("unroll") for (int n = 0; n < 2; ++n) _Pragma("unroll") for (int k = 0; k < 2; ++k) dst[n][k] = *(const PG8_LAS bf16x8*)(lds + PG8_SB(b, h) + boff + n * 2048 + k * 1024); } while (0)
#define PG8_MMA(ai, bj, At, Bt) do { __builtin_amdgcn_s_setprio(1); _Pragma("unroll") for (int m = 0; m < 4; ++m) _Pragma("unroll") for (int n = 0; n < 2; ++n) _Pragma("unroll") for (int k = 0; k < 2; ++k) \
        acc[ai][bj][m][n] = __builtin_amdgcn_mfma_f32_16x16x32_bf16(Bt[n][k], At[m][k], acc[ai][bj][m][n], 0, 0, 0); __builtin_amdgcn_s_setprio(0); } while (0)
#define PG8_WAIT_V(n) asm volatile("s_waitcnt vmcnt(" #n ")" ::: "memory")
#define PG8_WAIT_L(n) asm volatile("s_waitcnt lgkmcnt(" #n ")" ::: "memory")
#define PG8_BAR __builtin_amdgcn_s_barrier()
#define PG8_SCHED __builtin_amdgcn_sched_barrier(0)
    Unit cur, nxt; int ui = 0;
    if (!S.next(0, cur)) return;
    f32x4 acc[2][2][4][2];
#pragma unroll
    for (int a = 0; a < 2; ++a)
#pragma unroll
        for (int b = 0; b < 2; ++b)
#pragma unroll
            for (int m = 0; m < 4; ++m)
#pragma unroll
                for (int n = 0; n < 2; ++n) acc[a][b][m][n] = (f32x4){0.f, 0.f, 0.f, 0.f};
    bf16x8 At[4][2], B0[2][2], B1[2][2];
    const char* cA = (const char*)g.A + (size_t)cur.pm * tstepA; const char* cB = (const char*)g.Bt + (size_t)cur.pn * tstepB;
    S.a_ready(cur);
    if constexpr (SP2) {
        PG8_STAGE(PG8_SB(0, 0), cB, voffB); PG8_STAGE(PG8_SB(0, 1), cB + hstepB, voffB); PG8_STAGE(PG8_SA(0, 0), cA, voffA); PG8_STAGE(PG8_SA(0, 1), cA + hstepA, voffA);
        if (wr == 1) PG8_BAR;
        PG8_WAIT_V(2); PG8_BAR;
        PG8_STAGE(PG8_SB(1, 0), cB + kstep, voffB); PG8_STAGE(PG8_SA(1, 0), cA + kstep, voffA); PG8_STAGE(PG8_SB(1, 1), cB + hstepB + kstep, voffB);
        PG8_WAIT_V(6); PG8_BAR;
    } else {
        PG8_STAGE(PG8_SB(0, 0), cB, voffB); PG8_STAGE(PG8_SA(0, 0), cA, voffA); PG8_STAGE(PG8_SB(0, 1), cB + hstepB, voffB); PG8_STAGE(PG8_SA(0, 1), cA + hstepA, voffA);
        if (wr == 1) PG8_BAR;
        PG8_WAIT_V(4); PG8_BAR;
        PG8_STAGE(PG8_SB(1, 0), cB + kstep, voffB); PG8_STAGE(PG8_SA(1, 0), cA + kstep, voffA); PG8_STAGE(PG8_SB(1, 1), cB + hstepB + kstep, voffB);
        PG8_WAIT_V(6); PG8_BAR;
    }
    for (;;) {
        const bool has_next = S.next(ui + 1, nxt);
        const char* nA = has_next ? (const char*)g.A + (size_t)nxt.pm * tstepA : cA; const char* nB = has_next ? (const char*)g.Bt + (size_t)nxt.pn * tstepB : cB;
        for (int t = 0; t < nt; t += 2) {
            const bool last = (t == nt - 2);
            const char* a1 = cA + (size_t)(t + 1) * kstep;
            const char* a2 = last ? nA : cA + (size_t)(t + 2) * kstep; const char* b2 = last ? nB : cB + (size_t)(t + 2) * kstep;
            const char* a3 = a2 + kstep; const char* b3 = b2 + kstep;
            if (last && has_next) S.a_ready(nxt);
            if constexpr (SP2) {
            PG8_LDB(B0, 0, 0); PG8_LDB(B1, 0, 1); PG8_SCHED; PG8_LDA(At, 0, 0); PG8_STAGE(PG8_SA(1, 1), a1 + hstepA, voffA);
            PG8_WAIT_V(8); PG8_WAIT_L(0); PG8_BAR; PG8_MMA(0, 0, At, B0); PG8_MMA(0, 1, At, B1); PG8_BAR; PG8_SCHED;
            PG8_LDA(At, 0, 1); PG8_STAGE(PG8_SB(0, 0), b2, voffB); PG8_STAGE(PG8_SB(0, 1), b2 + hstepB, voffB); PG8_STAGE(PG8_SA(0, 0), a2, voffA);
            PG8_WAIT_V(8); PG8_WAIT_L(0); PG8_BAR; PG8_MMA(1, 0, At, B0); PG8_MMA(1, 1, At, B1); PG8_BAR; PG8_SCHED;
            PG8_LDB(B0, 1, 0); PG8_LDB(B1, 1, 1); PG8_SCHED; PG8_LDA(At, 1, 0); PG8_STAGE(PG8_SA(0, 1), a2 + hstepA, voffA);
            PG8_WAIT_V(8); PG8_WAIT_L(0); PG8_BAR; PG8_MMA(0, 0, At, B0); PG8_MMA(0, 1, At, B1); PG8_BAR; PG8_SCHED;
            PG8_LDA(At, 1, 1); PG8_STAGE(PG8_SB(1, 0), b3, voffB); PG8_STAGE(PG8_SB(1, 1), b3 + hstepB, voffB); PG8_STAGE(PG8_SA(1, 0), a3, voffA);
            PG8_WAIT_V(8); PG8_WAIT_L(0); PG8_BAR; PG8_MMA(1, 0, At, B0); PG8_MMA(1, 1, At, B1); PG8_BAR; PG8_SCHED;
            } else {
            PG8_LDB(B0, 0, 0); PG8_SCHED; PG8_LDA(At, 0, 0); PG8_STAGE(PG8_SA(1, 1), a1 + hstepA, voffA);
            PG8_WAIT_L(8); PG8_BAR; PG8_WAIT_L(0); PG8_MMA(0, 0, At, B0); PG8_BAR; PG8_SCHED;
            PG8_LDB(B1, 0, 1); PG8_STAGE(PG8_SB(0, 0), b2, voffB);
            PG8_BAR; PG8_WAIT_L(0); PG8_MMA(0, 1, At, B1); PG8_BAR;
            PG8_LDA(At, 0, 1); PG8_STAGE(PG8_SA(0, 0), a2, voffA);
            PG8_BAR; PG8_WAIT_L(0); PG8_MMA(1, 0, At, B0); PG8_BAR; PG8_SCHED;
            PG8_STAGE(PG8_SB(0, 1), b2 + hstepB, voffB);
            PG8_WAIT_V(6); PG8_BAR; PG8_MMA(1, 1, At, B1); PG8_BAR;
            PG8_LDB(B0, 1, 0); PG8_SCHED; PG8_LDA(At, 1, 0); PG8_STAGE(PG8_SA(0, 1), a2 + hstepA, voffA);
            PG8_WAIT_L(8); PG8_BAR; PG8_WAIT_L(0); PG8_MMA(0, 0, At, B0); PG8_BAR; PG8_SCHED;
            PG8_LDB(B1, 1, 1); PG8_STAGE(PG8_SB(1, 0), b3, voffB);
            PG8_BAR; PG8_WAIT_L(0); PG8_MMA(0, 1, At, B1); PG8_BAR;
            PG8_LDA(At, 1, 1); PG8_STAGE(PG8_SA(1, 0), a3, voffA);
            PG8_BAR; PG8_WAIT_L(0); PG8_MMA(1, 0, At, B0); PG8_BAR; PG8_SCHED;
            PG8_STAGE(PG8_SB(1, 1), b3 + hstepB, voffB);
            PG8_WAIT_V(6); PG8_BAR; PG8_MMA(1, 1, At, B1); PG8_BAR;
            }
        }
        if constexpr (ALIGN_EPI) { if (wr == 0) PG8_BAR; }
        if constexpr (!Epi::AFTER_DRAIN) { E(acc, cur, wr, wc, fr, fq); S.done(cur); }
        if (!has_next) break;
#pragma unroll
        for (int a = 0; a < 2; ++a)
#pragma unroll
            for (int b = 0; b < 2; ++b)
#pragma unroll
                for (int m = 0; m < 4; ++m)
#pragma unroll
                    for (int n = 0; n < 2; ++n) acc[a][b][m][n] = (f32x4){0.f, 0.f, 0.f, 0.f};
        cur = nxt; cA = nA; cB = nB; ++ui;
        if constexpr (ALIGN_EPI) { if (wr == 1) PG8_BAR; }
    }
    PG8_WAIT_V(0);
    if constexpr (!ALIGN_EPI) { if (wr == 0) PG8_BAR; }
    PG8_BAR;
    if constexpr (Epi::AFTER_DRAIN) { E.fused(acc, cur, wr, wc, fr, fq, lds, wid, lane); S.done(cur); }
#undef PG8_SA
#undef PG8_SB
#undef PG8_STAGE
#undef PG8_LDA
#undef PG8_LDB
#undef PG8_MMA
#undef PG8_WAIT_V
#undef PG8_WAIT_L
#undef PG8_BAR
#undef PG8_SCHED
}
}


struct EpiP1G {
    static constexpr bool PERM = true, AFTER_DRAIN = false;
    const Params* pp; int l; LAS float* xl;
    static constexpr int ROPE_LDS = 139264;
    static DI void st8(bf16_t* p, const float* v) { u32x4 w = {pk2(v[0], v[1]), pk2(v[2], v[3]), pk2(v[4], v[5]), pk2(v[6], v[7])}; *(u32x4*)p = w; }
    static DI void st8wt(bf16_t* p, const float* v) { u32x4 w = {pk2(v[0], v[1]), pk2(v[2], v[3]), pk2(v[4], v[5]), pk2(v[6], v[7])}; asm volatile("global_store_dwordx4 %0, %1, off sc1\n\ts_nop 1" :: "v"(p), "v"(w) : "memory"); }
    static DI void sf8(float* p, const float* v) { f32x4 a = {v[0], v[1], v[2], v[3]}, b = {v[4], v[5], v[6], v[7]}; *(f32x4*)p = a; *(f32x4*)(p + 4) = b; }
    DI void rope8(float* v, int t, int fq) const {
        LAS const float* tb = (LAS const float*)(xl + (ROPE_LDS - 131072) / 4) + ((fq >> 1) ? (t & 63) : (t >> 6)) * 16;
        const f32x4 c0 = *(LAS const f32x4*)tb, c1 = *(LAS const f32x4*)(tb + 4), s0 = *(LAS const f32x4*)(tb + 8), s1 = *(LAS const f32x4*)(tb + 12);
#pragma unroll
        for (int j = 0; j < 8; ++j) {
            const float pv = shx(v[j], 16);
            const float c = j < 4 ? c0[j & 3] : c1[j & 3], sn = j < 4 ? s0[j & 3] : s1[j & 3];
            v[j] = (fq & 1) ? v[j] * c + pv * sn : v[j] * c - pv * sn;
        }
    }
    static DI unsigned bperm(int a, unsigned v) { return (unsigned)__builtin_amdgcn_ds_bpermute(a, (int)v); }
    static DI u32x4 pack8t(const float* v, int bsrc) {
        u32x4 w = {pk2(v[0], v[1]), pk2(v[2], v[3]), pk2(v[4], v[5]), pk2(v[6], v[7])};
        u32x4 o = {bperm(bsrc, w[0]), bperm(bsrc, w[1]), bperm(bsrc, w[2]), bperm(bsrc, w[3])};
        return o;
    }
    static DI void st8t(bf16_t* p, const float* v, int bsrc) { *(u32x4*)p = pack8t(v, bsrc); }
    static DI void st8wtt(bf16_t* p, const float* v, int bsrc) { const u32x4 w = pack8t(v, bsrc); asm volatile("global_store_dwordx4 %0, %1, off sc1\n\ts_nop 1" :: "v"(p), "v"(w) : "memory"); }
    static DI void sf8t(float* p, const float* v, int bsrc) {
        f32x4 a, b;
#pragma unroll
        for (int j = 0; j < 4; ++j) { a[j] = __uint_as_float(bperm(bsrc, __float_as_uint(v[j]))); b[j] = __uint_as_float(bperm(bsrc, __float_as_uint(v[4 + j]))); }
        *(f32x4*)p = a; *(f32x4*)(p + 4) = b;
    }
    template <int CLS, int BJ>
    DI void rows(const pg8::f32x4 (&acc)[2][2][4][2], const pg8::Unit& u, int wr, int wc, int fr, int fq, int c32) const {
        const bool lat = u.pm >= 16;
        bf16_t* const U = (bf16_t*)(pp->ws + WS_U); bf16_t* const KC = (bf16_t*)(pp->ws + WS_KC); float* const SSQ = (float*)(pp->ws + WS_SSQ);
        float* const out = pp->out; const float* const gkv = pp->in[19] + l * 128;
        (void)U; (void)KC; (void)SSQ; (void)out; (void)gkv;
        const int ln = fq * 16 + fr, fr2 = ln >> 2, fq2 = ln & 3, bsrc = (fq2 * 16 + fr2) * 4;
        if constexpr (CLS == 6) {
            if constexpr (BJ == 0) {
#pragma unroll
                for (int ai = 0; ai < 2; ++ai)
#pragma unroll
                    for (int m = 0; m < 4; ++m) {
                        const int rloc = ai * 128 + wr * 64 + m * 16 + fr;
                        float ss = 0.f;
#pragma unroll
                        for (int j = 0; j < 4; ++j) ss += acc[ai][BJ][m][0][j] * acc[ai][BJ][m][0][j] + acc[ai][BJ][m][1][j] * acc[ai][BJ][m][1][j];
                        ss += shx(ss, 16); ss += shx(ss, 32);
                        if (fq == 0) xl[rloc * 4 + wc] = ss;
                    }
                asm volatile("s_waitcnt lgkmcnt(0)" ::: "memory"); __builtin_amdgcn_s_barrier(); asm volatile("" ::: "memory");
                const float* gp = gkv + (c32 - 72) * 32 + fq * 8;
                const f32x4 g0 = *(const f32x4*)gp, g1 = *(const f32x4*)(gp + 4);
#pragma unroll
                for (int ai = 0; ai < 2; ++ai)
#pragma unroll
                    for (int m = 0; m < 4; ++m) {
                        const int rb = ai * 128 + wr * 64 + m * 16, rloc = rb + fr, rloc2 = rb + fr2;
                        const f32x4 pp = *(LAS const f32x4*)(xl + rloc * 4);
                        const float rr = rsqrtf((pp[0] + pp[1] + pp[2] + pp[3]) * (1.f / 128.f) + eps_());
                        float v[8];
#pragma unroll
                        for (int j = 0; j < 4; ++j) { v[j] = acc[ai][BJ][m][0][j] * rr * g0[j]; v[4 + j] = acc[ai][BJ][m][1][j] * rr * g1[j]; }
                        if (!lat) sf8t(out + O_SCKV + ((size_t)(u.pm * 4 + l) * 256 + rloc2) * 128 + (c32 - 72) * 32 + fq2 * 8, v, bsrc);
                        st8wtt(U + (size_t)(u.pm * 256 + rloc2) * USTR + c32 * 32 + fq2 * 8, v, bsrc);
                        asm volatile("" ::: "memory");
                    }
                asm volatile("s_waitcnt lgkmcnt(0)" ::: "memory"); __builtin_amdgcn_s_barrier(); asm volatile("" ::: "memory");
            }
        } else {
#pragma unroll
            for (int ai = 0; ai < 2; ++ai)
#pragma unroll
                for (int m = 0; m < 4; ++m) {
                    const int rb = ai * 128 + wr * 64 + m * 16, rloc = rb + fr, r = u.pm * 256 + rloc, rloc2 = rb + fr2, r2 = u.pm * 256 + rloc2;
                    float v[8];
#pragma unroll
                    for (int j = 0; j < 4; ++j) { v[j] = acc[ai][BJ][m][0][j]; v[4 + j] = acc[ai][BJ][m][1][j]; }
                    bf16_t* up = U + (size_t)r2 * USTR + c32 * 32 + fq2 * 8;
                    const int t = (r - NCTX) & 2047;
                    const size_t srow = (size_t)(u.pm * 4 + l) * 256 + rloc2;
                    if constexpr (CLS == 0) {
                        if (lat) rope8(v, t, fq);
#pragma unroll
                        for (int j = 0; j < 8; ++j) v[j] *= SC_A;
                        st8t(up, v, bsrc);
                    } else if constexpr (CLS == 1) {
                        if (lat) rope8(v, t, fq); else sf8t(out + O_SAK + srow * 256 + (c32 - 8) * 32 + fq2 * 8, v, bsrc);
                        st8t(up, v, bsrc);
                    } else if constexpr (CLS == 2) {
                        if (!lat) sf8t(out + O_SAV + srow * 256 + (c32 - 16) * 32 + fq2 * 8, v, bsrc);
                        st8t(up, v, bsrc);
                    } else if constexpr (CLS == 3) {
#pragma unroll
                        for (int j = 0; j < 8; ++j) v[j] = siluf(v[j]);
                        st8t(up, v, bsrc);
                    } else if constexpr (CLS == 4) {
                        st8t(up, v, bsrc);
                    } else if constexpr (CLS == 5) {
                        float ss = 0.f;
#pragma unroll
                        for (int j = 0; j < 8; ++j) ss += v[j] * v[j];
                        ss += shx(ss, 16); ss += shx(ss, 32);
                        if (fq == 0) __hip_atomic_store((unsigned*)(SSQ + (size_t)r * 8 + (c32 - 64)), __float_as_uint(ss), __ATOMIC_RELAXED, __HIP_MEMORY_SCOPE_AGENT);
                        st8wtt(up, v, bsrc);
                    } else if constexpr (CLS == 7) {
#pragma unroll
                        for (int j = 0; j < 8; ++j) v[j] *= SC_D;
                        st8t(up, v, bsrc);
                    } else if constexpr (CLS == 8) {
                        if (!lat) sf8t(out + O_SDK + srow * 256 + (c32 - 92) * 32 + fq2 * 8, v, bsrc);
                        st8t(up, v, bsrc);
                    } else if constexpr (CLS == 9) {
                        if (!lat) sf8t(out + O_SDV + srow * 256 + (c32 - 100) * 32 + fq2 * 8, v, bsrc);
                        st8t(up, v, bsrc);
                    } else if constexpr (CLS == 10) {
                        if (lat) rope8(v, t, fq); else sf8t(out + O_SKPE + srow * 32 + fq2 * 8, v, bsrc);
                        bf16_t* kr = KC + (size_t)r2 * KCS + 64 + fq2 * 8;
                        const u32x4 w = pack8t(v, bsrc);
#pragma unroll
                        for (int h = 0; h < 4; ++h) *(u32x4*)(kr + h * 160) = w;
                    }
                    asm volatile("" ::: "memory");
                }
        }
    }
    template <int BJ>
    DI void half(const pg8::f32x4 (&acc)[2][2][4][2], const pg8::Unit& u, int wr, int wc, int fr, int fq) const {
        const int c32 = u.pn * 8 + BJ * 4 + wc;
        if (c32 < 8) rows<0, BJ>(acc, u, wr, wc, fr, fq, c32);
        else if (c32 < 16) rows<1, BJ>(acc, u, wr, wc, fr, fq, c32);
        else if (c32 < 24) rows<2, BJ>(acc, u, wr, wc, fr, fq, c32);
        else if (c32 < 32 || (c32 >= 56 && c32 < 64) || (c32 >= 76 && c32 < 84) || (c32 >= 108 && c32 < 116)) rows<3, BJ>(acc, u, wr, wc, fr, fq, c32);
        else if (c32 < 56) rows<4, BJ>(acc, u, wr, wc, fr, fq, c32);
        else if (c32 < 72) rows<5, BJ>(acc, u, wr, wc, fr, fq, c32);
        else if (c32 < 76) rows<6, BJ>(acc, u, wr, wc, fr, fq, c32);
        else if (c32 < 92) rows<7, BJ>(acc, u, wr, wc, fr, fq, c32);
        else if (c32 < 100) rows<8, BJ>(acc, u, wr, wc, fr, fq, c32);
        else if (c32 < 108) rows<9, BJ>(acc, u, wr, wc, fr, fq, c32);
        else if (c32 == 116) rows<10, BJ>(acc, u, wr, wc, fr, fq, c32);
    }
    DI void operator()(const pg8::f32x4 (&acc)[2][2][4][2], const pg8::Unit& u, int wr, int wc, int fr, int fq) const {
        asm volatile("" : "+v"(fr), "+v"(fq));
        half<0>(acc, u, wr, wc, fr, fq);
        half<1>(acc, u, wr, wc, fr, fq);
    }
};


DI void store16_wt(void* p, u32x4 v) { asm volatile("global_store_dwordx4 %0, %1, off sc1\n\ts_nop 1" :: "v"(p), "v"(v)); }
DI void store16_wt(void* p, f32x4 v) { asm volatile("global_store_dwordx4 %0, %1, off sc1\n\ts_nop 1" :: "v"(p), "v"(v)); }
DI void dep_signal(unsigned* ctr) {
    asm volatile("s_waitcnt vmcnt(0)" ::: "memory");
    __syncthreads();
    if (tidx() == 0) (void)__hip_atomic_fetch_add(ctr, 1u, __ATOMIC_RELAXED, __HIP_MEMORY_SCOPE_AGENT);
}
DI void dep_wait(unsigned* ctr, unsigned target) {
    if (tidx() == 0) {
        unsigned sp = 0;
        while (__hip_atomic_load(ctr, __ATOMIC_RELAXED, __HIP_MEMORY_SCOPE_AGENT) < target) {
            __builtin_amdgcn_s_sleep(2);
            if (++sp > (1u << 22)) break;
        }
        __builtin_amdgcn_fence(__ATOMIC_ACQUIRE, "agent");
        asm volatile("s_waitcnt vmcnt(0)" ::: "memory");
    }
    __syncthreads();
}

struct EpiP3G {
    static constexpr bool PERM = true, AFTER_DRAIN = false;
    const Params* pp; int layer;
    DI void operator()(const pg8::f32x4 (&acc)[2][2][4][2], const pg8::Unit& u, int wr, int wc, int fr, int fq) const {
        asm volatile("" : "+v"(fr), "+v"(fq));
        const float* const x0c = pp->in[0]; const float* const x0l = pp->in[1]; float* const out = pp->out; const float* const mod = (const float*)(pp->ws + WS_MOD);
        const int mi = (u.pm < 16) ? 0 : 1 + ((u.pm - 16) >> 3);
        const float* gate = mod + (size_t)(layer * 5 + mi) * 3072 + 2048;
        const int rbase = u.pm * 256 + wr * 64 + fr;
        bf16_t* const XBp = (bf16_t*)(pp->ws + WS_XB);
#pragma unroll
        for (int bj = 0; bj < 2; ++bj) {
            const int c8 = u.pn * 256 + bj * 128 + wc * 32 + fq * 8;
            const f32x4 g0 = *(const f32x4*)(gate + c8), g1 = *(const f32x4*)(gate + c8 + 4);
            if (layer == 0) {
                const float* xin0 = (u.pm < 16) ? x0c + (size_t)rbase * DM : x0l + (size_t)(rbase - NCTX) * DM;
                f32x4 xa[2][4], xq[2][4];
#pragma unroll
                for (int ai = 0; ai < 2; ++ai)
#pragma unroll
                    for (int m = 0; m < 4; ++m) { const float* xp = xin0 + (size_t)(ai * 128 + m * 16) * DM + c8; xa[ai][m] = *(const f32x4*)xp; xq[ai][m] = *(const f32x4*)(xp + 4); }
#pragma unroll
                for (int ai = 0; ai < 2; ++ai)
#pragma unroll
                    for (int m = 0; m < 4; ++m) {
                        const f32x4 a = xa[ai][m] + g0 * acc[ai][bj][m][0], b = xq[ai][m] + g1 * acc[ai][bj][m][1];
                        u32x4 wv = {pk2(a[0], a[1]), pk2(a[2], a[3]), pk2(b[0], b[1]), pk2(b[2], b[3])};
                        *(u32x4*)(XBp + (size_t)(rbase + ai * 128 + m * 16) * DM + c8) = wv;
                    }
            } else {
                u32x4 xv[2][4];
#pragma unroll
                for (int ai = 0; ai < 2; ++ai)
#pragma unroll
                    for (int m = 0; m < 4; ++m) xv[ai][m] = *(const u32x4*)(XBp + (size_t)(rbase + ai * 128 + m * 16) * DM + c8);
#pragma unroll
                for (int ai = 0; ai < 2; ++ai)
#pragma unroll
                    for (int m = 0; m < 4; ++m) {
                        const u32x4 w4 = xv[ai][m];
                        f32x4 a = {bf2f(w4[0] & 0xffffu), bf2f(w4[0] >> 16), bf2f(w4[1] & 0xffffu), bf2f(w4[1] >> 16)};
                        f32x4 b = {bf2f(w4[2] & 0xffffu), bf2f(w4[2] >> 16), bf2f(w4[3] & 0xffffu), bf2f(w4[3] >> 16)};
                        a = a + g0 * acc[ai][bj][m][0]; b = b + g1 * acc[ai][bj][m][1];
                        const size_t ro = (size_t)(rbase + ai * 128 + m * 16) * DM + c8;
                        u32x4 wv = {pk2(a[0], a[1]), pk2(a[2], a[3]), pk2(b[0], b[1]), pk2(b[2], b[3])};
                        if (layer + 1 < DEPTH) *(u32x4*)(XBp + ro) = wv;
                        else store16_wt(XBp + ro, wv);
                    }
            }
        }
    }
};

struct ARowPlain { const bf16_t* base; int ld; DI const bf16_t* row(int m) const { return base + (size_t)m * ld; } };

struct EpiP1 {
    bf16_t* U; bf16_t* KC; float* SSQ; const float* rope; float* out; const float* gkv; int l;
    DI void operator()(int m, int c32, float* v) const {
        const bool lat = (m >= NCTX);
        const int t = (m - NCTX) & 2047;
        const size_t srow = lat ? 0 : ((size_t)((m >> 8) * 4 + l) * 256 + (m & 255));
        bf16_t* urow = U + (size_t)m * USTR + c32 * 32;
        if (c32 < 8) {
            if (lat) rope32(v, rope, t);
#pragma unroll
            for (int j = 0; j < 32; ++j) v[j] *= SC_A;
            store_bf16x32(urow, v);
        } else if (c32 < 16) {
            if (lat) rope32(v, rope, t); else store_f32x32(out + O_SAK + srow * 256 + (c32 - 8) * 32, v);
            store_bf16x32(urow, v);
        } else if (c32 < 24) {
            if (!lat) store_f32x32(out + O_SAV + srow * 256 + (c32 - 16) * 32, v);
            store_bf16x32(urow, v);
        } else if (c32 < 32 || (c32 >= 56 && c32 < 64) || (c32 >= 76 && c32 < 84) || (c32 >= 108 && c32 < 116)) {
#pragma unroll
            for (int j = 0; j < 32; ++j) v[j] = siluf(v[j]);
            store_bf16x32(urow, v);
        } else if (c32 < 56) {
            store_bf16x32(urow, v);
        } else if (c32 < 72) {
            float ss = 0.f;
#pragma unroll
            for (int j = 0; j < 32; ++j) ss += v[j] * v[j];
            SSQ[(size_t)m * 8 + (c32 - 64)] = ss;
            store_bf16x32(urow, v);
        } else if (c32 < 76) {
            float ss = 0.f;
#pragma unroll
            for (int j = 0; j < 32; ++j) ss += v[j] * v[j];
            ss += shx(ss, 1);
            ss += shx(ss, 2);
            const float r = rsqrtf(ss * (1.f / 128.f) + eps_());
            const float* gp = gkv + (c32 - 72) * 32;
#pragma unroll
            for (int j = 0; j < 32; ++j) v[j] = v[j] * r * gp[j];
            if (!lat) store_f32x32(out + O_SCKV + srow * 128 + (c32 - 72) * 32, v);
            store_bf16x32(urow, v);
        } else if (c32 < 92) {
#pragma unroll
            for (int j = 0; j < 32; ++j) v[j] *= SC_D;
            store_bf16x32(urow, v);
        } else if (c32 < 100) {
            if (!lat) store_f32x32(out + O_SDK + srow * 256 + (c32 - 92) * 32, v);
            store_bf16x32(urow, v);
        } else if (c32 < 108) {
            if (!lat) store_f32x32(out + O_SDV + srow * 256 + (c32 - 100) * 32, v);
            store_bf16x32(urow, v);
        } else if (c32 == 116) {
            if (lat) rope32(v, rope, t); else store_f32x32(out + O_SKPE + srow * 32, v);
            bf16_t* kr = KC + (size_t)m * KCS + 64;
#pragma unroll
            for (int h = 0; h < 4; ++h) store_bf16x32(kr + h * 160, v);
        }
    }
};

struct P1Order {
    int G, c; unsigned* dep;
    DI bool next(int i, pg8::Unit& u) const {
        const int L = i * G + c;
        if (L < 96) { u.pm = L >> 1; u.pn = 8 + (L & 1); return true; }
        const int L2 = L - 96;
        if (L2 >= 624) return false;
        constexpr int nM = 48, nN = 13, nwg = 624, NX = 8, WG = 8;
        int wgid = L2; { const int q = nwg / NX, xcd = wgid % NX, off = wgid / NX; wgid = xcd * q + off; }
        const int nig = WG * nN, gid = wgid / nig, fm = gid * WG, gsz = (nM - fm) < WG ? (nM - fm) : WG;
        u.pm = fm + ((wgid % nig) % gsz);
        const int pn = (wgid % nig) / gsz;
        u.pn = pn < 8 ? pn : pn + 2;
        return true;
    }
    DI void a_ready(const pg8::Unit&) const {}
    DI void done(const pg8::Unit& u) const {
        if (u.pn == 8 || u.pn == 9) {
            asm volatile("s_waitcnt vmcnt(0)" ::: "memory");
            __builtin_amdgcn_s_barrier();
            if (tidx() == 0) (void)__hip_atomic_fetch_add(dep + u.pm, 1u, __ATOMIC_RELAXED, __HIP_MEMORY_SCOPE_AGENT);
        }
    }
};
struct OneUnit {
    int pn;
    DI bool next(int i, pg8::Unit& u) const { if (i) return false; u.pm = 0; u.pn = pn; return true; }
    DI void a_ready(const pg8::Unit&) const {}
    DI void done(const pg8::Unit&) const {}
};
struct EpiQG {
    static constexpr bool PERM = true, AFTER_DRAIN = false;
    const Params* pp; int row0; LAS const float* rope;
    DI void operator()(const pg8::f32x4 (&acc)[2][2][4][2], const pg8::Unit& u, int wr, int wc, int fr, int fq) const {
        asm volatile("" : "+v"(fr), "+v"(fq));
        bf16_t* const QC = (bf16_t*)(pp->ws + WS_QC); const float* const SSQ = (const float*)(pp->ws + WS_SSQ);
#pragma unroll
        for (int bj = 0; bj < 2; ++bj) {
            const int c32 = u.pn * 8 + bj * 4 + wc;
            if (c32 < 12) {
                const bool ropec = (c32 % 3) == 2;
#pragma unroll
                for (int ai = 0; ai < 2; ++ai)
#pragma unroll
                    for (int m = 0; m < 4; ++m) {
                        const int r = row0 + ai * 128 + wr * 64 + m * 16 + fr;
                        const f32x4 s0 = *(const f32x4*)(SSQ + (size_t)r * 8), s1 = *(const f32x4*)(SSQ + (size_t)r * 8 + 4);
                        const float rr = rsqrtf((s0[0] + s0[1] + s0[2] + s0[3] + s1[0] + s1[1] + s1[2] + s1[3]) * (1.f / 256.f) + eps_());
                        float v[8];
#pragma unroll
                        for (int j = 0; j < 4; ++j) { v[j] = acc[ai][bj][m][0][j] * rr; v[4 + j] = acc[ai][bj][m][1][j] * rr; }
                        if (ropec && r >= NCTX) {
                            const int t = (r - NCTX) & 2047;
                            LAS const float* tb = rope + ((fq >> 1) ? (t & 63) : (t >> 6)) * 16;
                            const f32x4 c0 = *(LAS const f32x4*)tb, c1 = *(LAS const f32x4*)(tb + 4), sn0 = *(LAS const f32x4*)(tb + 8), sn1 = *(LAS const f32x4*)(tb + 12);
#pragma unroll
                            for (int j = 0; j < 8; ++j) {
                                const float pv = shx(v[j], 16);
                                const float c = j < 4 ? c0[j & 3] : c1[j & 3], sn = j < 4 ? sn0[j & 3] : sn1[j & 3];
                                v[j] = (fq & 1) ? v[j] * c + pv * sn : v[j] * c - pv * sn;
                            }
                        }
#pragma unroll
                        for (int j = 0; j < 8; ++j) v[j] *= SC_C;
                        EpiP1G::st8(QC + (size_t)r * 384 + c32 * 32 + fq * 8, v);
                        asm volatile("" ::: "memory");
                    }
            }
        }
    }
};
struct EpiKVG {
    static constexpr bool PERM = true, AFTER_DRAIN = false;
    bf16_t* dst0;
    DI void operator()(const pg8::f32x4 (&acc)[2][2][4][2], const pg8::Unit& u, int wr, int wc, int fr, int fq) const {
        asm volatile("" : "+v"(fr), "+v"(fq));
#pragma unroll
        for (int bj = 0; bj < 2; ++bj) {
            const int c32 = u.pn * 8 + bj * 4 + wc, head = c32 >> 2, part = c32 & 3;
            const int coff = head * 160 + (part < 2 ? part * 32 : 96 + (part - 2) * 32) + fq * 8;
#pragma unroll
            for (int ai = 0; ai < 2; ++ai)
#pragma unroll
                for (int m = 0; m < 4; ++m) {
                    const int rl = ai * 128 + wr * 64 + m * 16 + fr;
                    float v[8];
#pragma unroll
                    for (int j = 0; j < 4; ++j) { v[j] = acc[ai][bj][m][0][j]; v[4 + j] = acc[ai][bj][m][1][j]; }
                    EpiP1G::st8(dst0 + (size_t)rl * KCS + coff, v);
                }
        }
    }
};
struct PQUnit {
    int pm, pn; unsigned* sig;
    DI bool next(int i, pg8::Unit& u) const { if (i) return false; u.pm = pm; u.pn = pn; return true; }
    DI void a_ready(const pg8::Unit&) const {}
    DI void done(const pg8::Unit& u) const {
        if (sig != nullptr) {
            asm volatile("s_waitcnt vmcnt(0)" ::: "memory");
            __builtin_amdgcn_s_barrier();
            if (tidx() == 0) (void)__hip_atomic_fetch_add(sig + u.pm, 1u, __ATOMIC_RELAXED, __HIP_MEMORY_SCOPE_AGENT);
        }
    }
};
constexpr int NP1B_UNITS = 208;
DI void phaseP1(const Params& P, LAS unsigned char* lds, int layer, int phase_id) {
    unsigned* dep = (unsigned*)(P.ws + WS_CTL) + CW_DEP + 64 * phase_id;
    ((LAS f32x2*)(lds + EpiP1G::ROPE_LDS))[tidx()] = ((const f32x2*)(P.ws + WS_ROPE))[tidx()];
    __syncthreads();
    {
        pg8::Gemm g{(const bf16_t*)(P.ws + WS_H), (const bf16_t*)(P.ws + WS_WIN) + (size_t)layer * NPADW * 1024, NTOK, NPADW, 1024, 0};
        P1Order S{(int)gridDim.x, bidx(), dep};
        EpiP1G E{&P, layer, (LAS float*)(lds + 131072)};
        pg8::gemm_phase<EpiP1G, P1Order, true, true>(lds, g, S, E);
    }
    unsigned* qctr = (unsigned*)(P.ws + WS_CTL) + CW_QUEUE + 64 * phase_id;
    LAS volatile int* sitem = (LAS volatile int*)(lds + LDS_CTLOFF + 16);
    const bf16_t* U = (const bf16_t*)(P.ws + WS_U);
    for (;;) {
        if (tidx() == 0) *sitem = (int)atomicAdd(qctr, 1u);
        __syncthreads();
        const int c = *sitem;
        __syncthreads();
        if (c >= NP1B_UNITS) break;
        if (c < 96) {
            const int pm = c >> 1;
            dep_wait(dep + pm, 2u);
            pg8::Gemm g{U + (size_t)pm * 256 * USTR + U_CQ, (const bf16_t*)(P.ws + WS_WUQ) + (size_t)layer * 384 * 256, 256, 512, 256, USTR};
            OneUnit S{c & 1};
            EpiQG E{&P, pm * 256, (LAS const float*)(lds + EpiP1G::ROPE_LDS)};
            pg8::gemm_phase<EpiQG, OneUnit, true, false>(lds, g, S, E);
        } else {
            const bf16_t* A; bf16_t* dst; int lda;
            if (c < 192) {
                const int pm = (c - 96) >> 1;
                dep_wait(dep + pm, 2u);
                A = U + (size_t)pm * 256 * USTR + U_CKV; lda = USTR; dst = (bf16_t*)(P.ws + WS_KC) + (size_t)pm * 256 * KCS;
            } else {
                const int pq = (c - 192) >> 1, b = pq >> 1, half = pq & 1;
                A = (const bf16_t*)(P.ws + WS_CKVC) + ((size_t)(b * 4 + layer) * 512 + half * 256) * 128; lda = 128;
                dst = (bf16_t*)(P.ws + WS_KCC) + ((size_t)(layer * 4 + b) * 512 + half * 256) * KCS;
            }
            pg8::Gemm g{A, (const bf16_t*)(P.ws + WS_WUKV) + (size_t)layer * 512 * 128, 256, 512, 128, lda};
            OneUnit S{c & 1};
            EpiKVG E{dst};
            pg8::gemm_phase<EpiKVG, OneUnit, true, false>(lds, g, S, E);
        }
    }
}

struct EpiQ {
    bf16_t* QC; const float* SSQ; const float* rope;
    DI void operator()(int m, int c32, float* v) const {
        const f32x4 s0 = *(const f32x4*)(SSQ + (size_t)m * 8), s1 = *(const f32x4*)(SSQ + (size_t)m * 8 + 4);
        const float ss = s0[0] + s0[1] + s0[2] + s0[3] + s1[0] + s1[1] + s1[2] + s1[3];
        const float r = rsqrtf(ss * (1.f / 256.f) + eps_());
#pragma unroll
        for (int j = 0; j < 32; ++j) v[j] *= r;
        if ((c32 % 3) == 2 && m >= NCTX) rope32(v, rope, (m - NCTX) & 2047);
#pragma unroll
        for (int j = 0; j < 32; ++j) v[j] *= SC_C;
        store_bf16x32(QC + (size_t)m * 384 + c32 * 32, v);
    }
};
struct ARowKV {
    const bf16_t* U; const bf16_t* ckvc; int l;
    DI const bf16_t* row(int m) const {
        if (m < NTOK) return U + (size_t)m * USTR + U_CKV;
        const int mm = m - NTOK, b = mm >> 9, t = mm & 511;
        return ckvc + ((size_t)(b * 4 + l) * 512 + t) * 128;
    }
};
struct EpiKV {
    bf16_t* KC; bf16_t* KCC; int l;
    DI void operator()(int m, int c32, float* v) const {
        const int head = c32 >> 2, part = c32 & 3;
        bf16_t* dst;
        if (m < NTOK) dst = KC + (size_t)m * KCS;
        else { const int mm = m - NTOK, b = mm >> 9, t = mm & 511; dst = KCC + ((size_t)(l * 4 + b) * 512 + t) * KCS; }
        dst += head * 160 + (part < 2 ? part * 32 : 96 + (part - 2) * 32);
        store_bf16x32(dst, v);
    }
};
struct AttnDesc {
    const bf16_t* q; int qs;
    const bf16_t* k0; const bf16_t* v0; int ks0, vs0, nt0;
    const bf16_t* k1; const bf16_t* v1; int ks1, vs1;
    int nt;
    bf16_t* out; const bf16_t* sz;
    float lam, oml; const float* subg;
    const float* rpb; int qrow0, rs;
};

template <int MODE, bool FAST>
DI bool attn_unit(const AttnDesc& d, LAS unsigned char* lds, unsigned* qctr, unsigned* pend) {
    constexpr int DQK = (MODE == 1) ? 96 : 64;
    constexpr int NMAP = (MODE == 0) ? 2 : 1;
    constexpr int NKK = DQK / 16;
    constexpr int KSTR = DQK * 2 + 16;
    constexpr int NKC = DQK / 8;
    constexpr int NKL = (64 * NKC + NT - 1) / NT;
    constexpr int KBUF = 64 * KSTR;
    constexpr int VOFF = 2 * 64 * 208;
    constexpr int BOFF = VOFF + 16384;
    constexpr float THR = 6.f;
    const int tid = tidx(), lane = tid & 63, r32 = lane & 31, hh = lane >> 5;
    const int w = __builtin_amdgcn_readfirstlane(tid >> 6);

    const bool nawin = (MODE == 2) && (d.rpb != nullptr);
    auto tokmap = [&](int q) { return nawin ? ((2 * (w >> 2) + (q >> 4)) * 64 + (w & 3) * 16 + (q & 15)) : (w * 32 + q); };
    bf16x8 qf[NKK];
    {
        const bf16_t* qrow = d.q + (size_t)tokmap(r32) * d.qs + hh * 8;
#pragma unroll
        for (int kk = 0; kk < NKK; ++kk) qf[kk] = *(const bf16x8*)(qrow + kk * 16);
    }
    const bool has_bias = nawin;
    if (MODE == 2 && has_bias) {
        LAS float* bt = (LAS float*)(lds + BOFF);
        for (int idx = tid; idx < 15 * 31; idx += NT) bt[(idx / 31) * 32 + (idx % 31)] = d.rpb[idx] * LOG2E;
    }
    float m[NMAP], l[NMAP];
    f32x16 o[NMAP][2];
#pragma unroll
    for (int mp = 0; mp < NMAP; ++mp) {
        m[mp] = NEGBIG; l[mp] = 0.f;
#pragma unroll
        for (int i = 0; i < 16; ++i) { o[mp][0][i] = 0.f; o[mp][1][i] = 0.f; }
    }
    u32x4 kregA[NKL], vregA, kregB[NKL], vregB;
    unsigned koff0[NKL], koff1[NKL], voff0, voff1;
#pragma unroll
    for (int i = 0; i < NKL; ++i) { const int c = tid + NT * i; const unsigned row = (unsigned)c / NKC, ch = (unsigned)c % NKC; koff0[i] = row * (unsigned)(d.ks0 * 2) + ch * 16u; koff1[i] = row * (unsigned)(d.ks1 * 2) + ch * 16u; }
    { const unsigned row = (unsigned)tid >> 3, ch = (unsigned)tid & 7u; voff0 = row * (unsigned)(d.vs0 * 2) + ch * 16u; voff1 = row * (unsigned)(d.vs1 * 2) + ch * 16u; }
    auto load_tile = [&](int t, u32x4 (&kr)[NKL], u32x4& vr) {
        const bool s0 = t < d.nt0;
        const int tt = s0 ? t : t - d.nt0;
        const unsigned ks2 = (unsigned)(s0 ? d.ks0 : d.ks1) * 2u, vs2 = (unsigned)(s0 ? d.vs0 : d.vs1) * 2u;
        const char* kb = (const char*)(s0 ? d.k0 : d.k1) + (size_t)tt * 64 * ks2;
        const char* vb = (const char*)(s0 ? d.v0 : d.v1) + (size_t)tt * 64 * vs2;
        if (t == d.nt0) {
#pragma unroll
            for (int i = 0; i < NKL; ++i) koff0[i] = koff1[i];
            voff0 = voff1;
        }
#pragma unroll
        for (int i = 0; i < NKL; ++i) { const int c = tid + NT * i; asm("" : "+v"(koff0[i])); if (c < 64 * NKC) kr[i] = *(const u32x4*)(kb + koff0[i]); }
        { asm("" : "+v"(voff0)); vr = *(const u32x4*)(vb + voff0); }
    };
    auto store_tile = [&](int buf, const u32x4 (&kr)[NKL], const u32x4& vr) {
        LAS unsigned char* kd = lds + buf * KBUF;
        LAS unsigned char* vd = lds + VOFF + buf * 8192;
#pragma unroll
        for (int i = 0; i < NKL; ++i) { const int c = tid + NT * i, row = c / NKC, ch = c % NKC; if (c < 64 * NKC) *(LAS u32x4*)(kd + row * KSTR + ch * 16) = kr[i]; }
        { const int row = tid >> 3, ch = tid & 7; *(LAS u32x4*)(vd + row * 128 + ((ch * 16) ^ (((row >> 1) & 1) << 6))) = vr; }
    };
    const int q4 = (lane & 15) >> 2, p4 = lane & 3, g16 = (lane >> 4) & 1, xs = (q4 >> 1) & 1;
    const int vlane = (4 * hh + q4) * 128 + g16 * 32 + p4 * 8;
    const int rqA = d.qrow0 + 2 * (w >> 2);
    const int rstA = min(max(rqA - 4, 0), 24), rstB = min(max(rqA - 3, 0), 24);
    const int cst = min(max((w & 3) * 16 - 8, 0), 32);

    auto tile_body = [&](int t, int cur) {
        {
            LAS const unsigned char* kb = lds + cur * KBUF;
            LAS const unsigned char* vb = lds + VOFF + cur * 8192;
            bf16x8 kf[2][NKK];
#pragma unroll
            for (int sub = 0; sub < 2; ++sub)
#pragma unroll
                for (int kk = 0; kk < NKK; ++kk) kf[sub][kk] = *(LAS const bf16x8*)(kb + (sub * 32 + r32) * KSTR + kk * 32 + hh * 16);
            bf16x8 vfr[2][2][2];
            auto vread = [&](int sub, int st, int dvb) {
                LAS const unsigned char* va = vb + vlane + (sub * 32 + st * 16) * 128 + ((dvb ^ xs) * 64);
                const s16x4 lo = __builtin_bit_cast(s16x4, __builtin_amdgcn_ds_read_tr16_b64_v4i16((LAS s16x4*)(va)));
                const s16x4 hi = __builtin_bit_cast(s16x4, __builtin_amdgcn_ds_read_tr16_b64_v4i16((LAS s16x4*)(va + 8 * 128)));
                const bf16x8 vf = {lo[0], lo[1], lo[2], lo[3], hi[0], hi[1], hi[2], hi[3]};
                return vf;
            };
#pragma unroll
            for (int st = 0; st < 2; ++st)
#pragma unroll
                for (int dvb = 0; dvb < 2; ++dvb) vfr[0][st][dvb] = vread(0, st, dvb);
            __builtin_amdgcn_sched_barrier(0);
            bf16x8 pf[NMAP][2][2];
#pragma unroll
            for (int mp = 0; mp < NMAP; ++mp) {
                f32x16 s[2];
#pragma unroll
                for (int sub = 0; sub < 2; ++sub) {
#pragma unroll
                    for (int i = 0; i < 16; ++i) s[sub][i] = 0.f;
#pragma unroll
                    for (int k2 = 0; k2 < NKK / NMAP; ++k2) {
                        const int kk = mp * (NKK / NMAP) + k2;
                        s[sub] = __builtin_amdgcn_mfma_f32_32x32x16_bf16(kf[sub][kk], qf[kk], s[sub], 0, 0, 0);
                    }
                }
                if constexpr (FAST) {
                    float ps0 = 0.f, ps1 = 0.f, ps2 = 0.f, ps3 = 0.f;
#pragma unroll
                    for (int sub = 0; sub < 2; ++sub)
#pragma unroll
                        for (int i = 0; i < 16; i += 4) {
                            const float p0 = __builtin_amdgcn_exp2f(s[sub][i]), p1 = __builtin_amdgcn_exp2f(s[sub][i + 1]);
                            const float p2 = __builtin_amdgcn_exp2f(s[sub][i + 2]), p3 = __builtin_amdgcn_exp2f(s[sub][i + 3]);
                            s[sub][i] = p0; s[sub][i + 1] = p1; s[sub][i + 2] = p2; s[sub][i + 3] = p3;
                            ps0 += p0; ps1 += p1; ps2 += p2; ps3 += p3;
                        }
                    l[mp] += (ps0 + ps1) + (ps2 + ps3);
                } else {
                float mx = s[0][0];
#pragma unroll
                for (int i = 1; i < 16; ++i) mx = fmaxf(mx, s[0][i]);
#pragma unroll
                for (int i = 0; i < 16; ++i) mx = fmaxf(mx, s[1][i]);
                mx = half_swap_max(mx);
                const float mnew = fmaxf(m[mp], mx);
                if (__any((mnew - m[mp]) > THR)) {
                    const float alpha = __builtin_amdgcn_exp2f(m[mp] - mnew);
#pragma unroll
                    for (int i = 0; i < 16; ++i) { o[mp][0][i] *= alpha; o[mp][1][i] *= alpha; }
                    l[mp] *= alpha;
                    m[mp] = mnew;
                }
                float ps = 0.f;
#pragma unroll
                for (int sub = 0; sub < 2; ++sub)
#pragma unroll
                    for (int i = 0; i < 16; ++i) { const float p = __builtin_amdgcn_exp2f(s[sub][i] - m[mp]); s[sub][i] = p; ps += p; }
                l[mp] += ps;
                }
#pragma unroll
                for (int sub = 0; sub < 2; ++sub)
#pragma unroll
                    for (int st = 0; st < 2; ++st) {
                        u32x4 pw = {pk2(s[sub][8 * st], s[sub][8 * st + 1]), pk2(s[sub][8 * st + 2], s[sub][8 * st + 3]),
                                    pk2(s[sub][8 * st + 4], s[sub][8 * st + 5]), pk2(s[sub][8 * st + 6], s[sub][8 * st + 7])};
                        pf[mp][sub][st] = __builtin_bit_cast(bf16x8, pw);
                    }
#pragma unroll
                for (int st = 0; st < 2; ++st)
#pragma unroll
                    for (int dvb = 0; dvb < 2; ++dvb) o[mp][dvb] = __builtin_amdgcn_mfma_f32_32x32x16_bf16(vfr[0][st][dvb], pf[mp][0][st], o[mp][dvb], 0, 0, 0);
            }
#pragma unroll
            for (int st = 0; st < 2; ++st)
#pragma unroll
                for (int dvb = 0; dvb < 2; ++dvb) vfr[1][st][dvb] = vread(1, st, dvb);
#pragma unroll
            for (int st = 0; st < 2; ++st)
#pragma unroll
                for (int dvb = 0; dvb < 2; ++dvb) {
#pragma unroll
                    for (int mp = 0; mp < NMAP; ++mp) o[mp][dvb] = __builtin_amdgcn_mfma_f32_32x32x16_bf16(vfr[1][st][dvb], pf[mp][1][st], o[mp][dvb], 0, 0, 0);
                }
        }
    };
    auto local_body = [&](int t, int cur) {
        const int krow = d.rs + (t - d.nt0);
        if (krow >= rstA && krow < rstB + 8) {
            LAS const unsigned char* kb = lds + cur * KBUF;
            LAS const unsigned char* vb = lds + VOFF + cur * 8192;
            bf16x8 kf1[NKK];
#pragma unroll
            for (int kk = 0; kk < NKK; ++kk) kf1[kk] = *(LAS const bf16x8*)(kb + (cst + r32) * KSTR + kk * 32 + hh * 16);
            bf16x8 vf1[2][2];
#pragma unroll
            for (int st = 0; st < 2; ++st)
#pragma unroll
                for (int dvb = 0; dvb < 2; ++dvb) {
                    LAS const unsigned char* va = vb + vlane + (cst + st * 16) * 128 + ((dvb ^ xs) * 64);
                    const s16x4 lo = __builtin_bit_cast(s16x4, __builtin_amdgcn_ds_read_tr16_b64_v4i16((LAS s16x4*)(va)));
                    const s16x4 hi = __builtin_bit_cast(s16x4, __builtin_amdgcn_ds_read_tr16_b64_v4i16((LAS s16x4*)(va + 8 * 128)));
                    vf1[st][dvb] = (bf16x8){lo[0], lo[1], lo[2], lo[3], hi[0], hi[1], hi[2], hi[3]};
                }
            __builtin_amdgcn_sched_barrier(0);
            f32x16 s1;
#pragma unroll
            for (int i = 0; i < 16; ++i) s1[i] = 0.f;
#pragma unroll
            for (int kk = 0; kk < NKK; ++kk) s1 = __builtin_amdgcn_mfma_f32_32x32x16_bf16(kf1[kk], qf[kk], s1, 0, 0, 0);
            {
                const int rql = rqA + (r32 >> 4), qcl = (w & 3) * 16 + (r32 & 15);
                const int rstl = min(max(rql - 4, 0), 24), wstl = min(max(qcl - 8, 0), 48);
                const bool rowok = (krow >= rstl) && (krow < rstl + 8);
                int kofs = rowok ? (cst + 4 * hh - wstl) : 4096;
                int bidx = (rowok ? (krow - rql + 7) : 0) * 32 + cst + 4 * hh - qcl + 15;
                asm volatile("" : "+v"(kofs), "+v"(bidx));
                LAS const float* bt = (LAS const float*)(lds + BOFF) + bidx;
#pragma unroll
                for (int i = 0; i < 16; ++i) {
                    const int kci = (i & 3) + 8 * (i >> 2);
                    const bool inw = (unsigned)(kci + kofs) < 16u;
                    s1[i] = inw ? s1[i] + bt[kci] : NEGBIG;
                }
            }
            if constexpr (FAST) {
                float ps0 = 0.f, ps1 = 0.f, ps2 = 0.f, ps3 = 0.f;
#pragma unroll
                for (int i = 0; i < 16; i += 4) {
                    const float p0 = __builtin_amdgcn_exp2f(s1[i]), p1 = __builtin_amdgcn_exp2f(s1[i + 1]);
                    const float p2 = __builtin_amdgcn_exp2f(s1[i + 2]), p3 = __builtin_amdgcn_exp2f(s1[i + 3]);
                    s1[i] = p0; s1[i + 1] = p1; s1[i + 2] = p2; s1[i + 3] = p3;
                    ps0 += p0; ps1 += p1; ps2 += p2; ps3 += p3;
                }
                l[0] += (ps0 + ps1) + (ps2 + ps3);
            } else {
                float mx = s1[0];
#pragma unroll
                for (int i = 1; i < 16; ++i) mx = fmaxf(mx, s1[i]);
                mx = half_swap_max(mx);
                const float mnew = fmaxf(m[0], mx);
                if (__any((mnew - m[0]) > THR)) {
                    const float alpha = __builtin_amdgcn_exp2f(m[0] - mnew);
#pragma unroll
                    for (int i = 0; i < 16; ++i) { o[0][0][i] *= alpha; o[0][1][i] *= alpha; }
                    l[0] *= alpha;
                    m[0] = mnew;
                }
                float ps = 0.f;
#pragma unroll
                for (int i = 0; i < 16; ++i) { const float p = __builtin_amdgcn_exp2f(s1[i] - m[0]); s1[i] = p; ps += p; }
                l[0] += ps;
            }
#pragma unroll
            for (int st = 0; st < 2; ++st) {
                u32x4 pw = {pk2(s1[8 * st], s1[8 * st + 1]), pk2(s1[8 * st + 2], s1[8 * st + 3]), pk2(s1[8 * st + 4], s1[8 * st + 5]), pk2(s1[8 * st + 6], s1[8 * st + 7])};
                const bf16x8 pfr = __builtin_bit_cast(bf16x8, pw);
#pragma unroll
                for (int dvb = 0; dvb < 2; ++dvb) o[0][dvb] = __builtin_amdgcn_mfma_f32_32x32x16_bf16(vf1[st][dvb], pfr, o[0][dvb], 0, 0, 0);
            }
        }
    };
    auto tile_any = [&](int t, int cur) { if (MODE == 2 && nawin && t >= d.nt0) local_body(t, cur); else tile_body(t, cur); };
    load_tile(0, kregA, vregA);
    if (d.nt > 1) load_tile(1, kregB, vregB);
    store_tile(0, kregA, vregA);
    __syncthreads();
    if (pend != nullptr && tid == 0) (void)__hip_atomic_fetch_add(pend, 1u, __ATOMIC_RELAXED, __HIP_MEMORY_SCOPE_AGENT);
    for (int t = 0; t < d.nt; t += 2) {
        if (t + 2 < d.nt) load_tile(t + 2, kregA, vregA);
        tile_any(t, 0);
        if (t + 1 < d.nt) store_tile(1, kregB, vregB);
        __syncthreads();
        if (t + 1 < d.nt) {
            if (t + 3 < d.nt) load_tile(t + 3, kregB, vregB);
            tile_any(t + 1, 1);
            if (t + 2 < d.nt) store_tile(0, kregA, vregA);
            __syncthreads();
        }
    }
    int nxt_item = 0;
    if (qctr != nullptr && tid == 0) nxt_item = (int)atomicAdd(qctr, 1u);
    u32x4 zv4[4];
#pragma unroll
    for (int i = 0; i < 4; ++i) { const int idx = lane + 64 * i, row = idx >> 3, ch = idx & 7; zv4[i] = *(const u32x4*)(d.sz + (size_t)tokmap(row) * USTR + ch * 8); }
    float y[2][16];
    {
        float inv[NMAP];
#pragma unroll
        for (int mp = 0; mp < NMAP; ++mp) {
            const float lt = half_swap_sum(l[mp]);
            if (FAST) { if (__any(!(lt > 1e-30f && lt < 1e30f)) && lane == 0) *(LAS volatile unsigned*)(lds + LDS_CTLOFF + 32) = 1u; }
            inv[mp] = 1.f / lt;
        }
        if (MODE == 0) {
            float ss = 0.f;
#pragma unroll
            for (int dvb = 0; dvb < 2; ++dvb)
#pragma unroll
                for (int i = 0; i < 16; ++i) { const float v = o[0][dvb][i] * inv[0] - d.lam * (o[NMAP - 1][dvb][i] * inv[NMAP - 1]); y[dvb][i] = v; ss += v * v; }
            ss = half_swap_sum(ss);
            const float r = rsqrtf(ss * (1.f / 64.f) + eps_()) * d.oml;
#pragma unroll
            for (int dvb = 0; dvb < 2; ++dvb)
#pragma unroll
                for (int i = 0; i < 16; ++i) y[dvb][i] *= r * d.subg[dvb * 32 + crow(i, hh)];
        } else {
#pragma unroll
            for (int dvb = 0; dvb < 2; ++dvb)
#pragma unroll
                for (int i = 0; i < 16; ++i) y[dvb][i] = o[0][dvb][i] * inv[0];
        }
    }
    LAS bf16_t* stg = (LAS bf16_t*)(lds + w * 32 * 144);
#pragma unroll
    for (int dvb = 0; dvb < 2; ++dvb)
#pragma unroll
        for (int i = 0; i < 16; ++i) stg[r32 * 72 + dvb * 32 + crow(i, hh)] = (bf16_t)(pk2(y[dvb][i], 0.f) & 0xffffu);
    __builtin_amdgcn_s_waitcnt(0xc07f);
#pragma unroll
    for (int i = 0; i < 4; ++i) {
        const int idx = lane + 64 * i, row = idx >> 3, ch = idx & 7;
        const u32x4 ov = *(LAS const u32x4*)((LAS const unsigned char*)stg + row * 144 + ch * 16);
        const u32x4 zv = zv4[i];
        u32x4 rv;
#pragma unroll
        for (int j = 0; j < 4; ++j) {
            const float a0 = bf2f(ov[j] & 0xffffu) * bf2f(zv[j] & 0xffffu), a1 = bf2f(ov[j] >> 16) * bf2f(zv[j] >> 16);
            rv[j] = pk2(a0, a1);
        }
        asm volatile("global_store_dwordx4 %0, %1, off sc1\n\ts_nop 1" :: "v"(d.out + (size_t)tokmap(row) * DM + ch * 8), "v"(rv) : "memory");
    }
    if (qctr != nullptr && tid == 0) *(LAS volatile int*)(lds + LDS_CTLOFF + 16) = nxt_item;
    __syncthreads();
    if (FAST) return *(LAS volatile unsigned*)(lds + LDS_CTLOFF + 32) == 0u;
    return true;
}

DI void conv_item(const Params& P, int layer, int tile) {
    const bf16_t* U = (const bf16_t*)(P.ws + WS_U);
    bf16_t* YG = (bf16_t*)(P.ws + WS_YG);
    const float* cw = P.in[16] + layer * 3 * 256;
    const int tid = tidx(), ch = tid & 31, gA = tile * 256 + (tid >> 5) * 16;
    float w[3][8];
#pragma unroll
    for (int dd = 0; dd < 3; ++dd) {
        const f32x4 w0 = *(const f32x4*)(cw + dd * 256 + ch * 8), w1 = *(const f32x4*)(cw + dd * 256 + ch * 8 + 4);
#pragma unroll
        for (int j = 0; j < 4; ++j) { w[dd][j] = w0[j]; w[dd][4 + j] = w1[j]; }
    }
    const int L = (gA < NCTX) ? 256 : 2048;
    const int tposA = (gA < NCTX) ? (gA & 255) : ((gA - NCTX) & 2047);
    const bf16_t* ur = U + (size_t)gA * USTR + ch * 8;
    auto prod = [&](u32x4 bc, u32x4 bh, bool ok, float* pr) {
#pragma unroll
        for (int j = 0; j < 4; ++j) {
            pr[2 * j] = ok ? bf2f(bc[j] & 0xffffu) * bf2f(bh[j] & 0xffffu) : 0.f;
            pr[2 * j + 1] = ok ? bf2f(bc[j] >> 16) * bf2f(bh[j] >> 16) : 0.f;
        }
    };
    float pm[8], pc[8];
    {
        const bf16_t* r0 = ur - USTR;
        const u32x4 bcm = *(const u32x4*)(r0 + U_BC), bhm = *(const u32x4*)(r0 + U_BH), bc0 = *(const u32x4*)(ur + U_BC), bh0 = *(const u32x4*)(ur + U_BH);
        prod(bcm, bhm, tposA > 0, pm);
        prod(bc0, bh0, true, pc);
    }
#pragma unroll
    for (int bt = 0; bt < 2; ++bt) {
        u32x4 BC[8], BH[8], BB[8], ZZ[8];
#pragma unroll
        for (int q = 0; q < 8; ++q) {
            const bf16_t* rq = ur + (size_t)(bt * 8 + q) * USTR;
            BB[q] = *(const u32x4*)(rq + U_BB); ZZ[q] = *(const u32x4*)(rq + U_BZ);
            BC[q] = *(const u32x4*)(rq + USTR + U_BC); BH[q] = *(const u32x4*)(rq + USTR + U_BH);
        }
#pragma unroll
        for (int q = 0; q < 8; ++q) {
            const int i = bt * 8 + q;
            float pn[8];
            prod(BC[q], BH[q], tposA + i + 1 < L, pn);
            u32x4 rv;
#pragma unroll
            for (int j = 0; j < 4; ++j) {
                const float a0 = (pm[2 * j] * w[0][2 * j] + pc[2 * j] * w[1][2 * j] + pn[2 * j] * w[2][2 * j]) * bf2f(BB[q][j] & 0xffffu) * bf2f(ZZ[q][j] & 0xffffu);
                const float a1 = (pm[2 * j + 1] * w[0][2 * j + 1] + pc[2 * j + 1] * w[1][2 * j + 1] + pn[2 * j + 1] * w[2][2 * j + 1]) * bf2f(BB[q][j] >> 16) * bf2f(ZZ[q][j] >> 16);
                rv[j] = pk2(a0, a1);
            }
            asm volatile("global_store_dwordx4 %0, %1, off sc1\n\ts_nop 1" :: "v"(YG + (size_t)(gA + i) * DM + 256 + ch * 8), "v"(rv) : "memory");
#pragma unroll
            for (int j = 0; j < 8; ++j) { pm[j] = pc[j]; pc[j] = pn[j]; }
        }
    }
}

constexpr int P2_ATT = 384 + 192 + 48, P2_OUT = 192, P2_ITEMS = P2_ATT + P2_OUT;
DI int rstart(int r) { return min(max(r - 4, 0), 24); }

DI int phaseP2(const Params& P, LAS unsigned char* lds, int layer, int phase_id) {
    const bf16_t* U = (const bf16_t*)(P.ws + WS_U);
    const bf16_t* KC = (const bf16_t*)(P.ws + WS_KC);
    const bf16_t* KCC = (const bf16_t*)(P.ws + WS_KCC);
    const bf16_t* QC = (const bf16_t*)(P.ws + WS_QC);
    bf16_t* YG = (bf16_t*)(P.ws + WS_YG);
    unsigned* ctr = (unsigned*)(P.ws + WS_CTL) + CW_QUEUE + 64 * phase_id;
    LAS volatile int* sitem = (LAS volatile int*)(lds + LDS_CTLOFF + 16);
    const float* lamp = (const float*)(P.ws + WS_LAM) + layer * 2;
    unsigned* dep = (unsigned*)(P.ws + WS_CTL) + CW_DEP + 64 * (phase_id & 31);
    int first_tail = 0;
    unsigned* pend = nullptr;
    if (tidx() == 0) *sitem = (int)atomicAdd(ctr, 1u);
    for (;;) {
        __syncthreads();
        const int item = *sitem;
        __syncthreads();
        if (tidx() == 0) *(LAS volatile unsigned*)(lds + LDS_CTLOFF + 32) = 0u;
        if (item >= 576 && pend != nullptr) { dep_signal(pend); pend = nullptr; }
        if (item >= P2_ATT) { first_tail = item; break; }
        AttnDesc d;
        d.k1 = nullptr; d.v1 = nullptr; d.ks1 = 0; d.vs1 = 0; d.rpb = nullptr; d.qrow0 = 0; d.rs = 0; d.lam = 0.f; d.oml = 0.f; d.subg = nullptr;
        if (item >= 576) {
            int nx = 0;
            if (tidx() == 0) nx = (int)atomicAdd(ctr, 1u);
            conv_item(P, layer, item - 576);
            dep_signal(dep + (item - 576));
            if (tidx() == 0) *sitem = nx;
            continue;
        }
        int kind, panel;
        if (item < 384) {
            const int j = item & 127, b = j >> 5, h = (j >> 3) & 3, qb = j & 7;
            kind = item >> 7; panel = 16 + b * 8 + qb;
            const size_t tokb = NCTX + (size_t)b * 2048, tok0 = tokb + qb * 256;
            const size_t crow0 = (size_t)(b * 4 + layer) * 512;
            d.nt0 = 8; d.nt = 40;
            if (kind == 0) {
                d.q = U + tok0 * USTR + U_AQ + h * 64; d.qs = USTR;
                d.k0 = (const bf16_t*)(P.ws + WS_CAK) + crow0 * 256 + h * 64; d.v0 = (const bf16_t*)(P.ws + WS_CAV) + crow0 * 256 + h * 64; d.ks0 = 256; d.vs0 = 256;
                d.k1 = U + tokb * USTR + U_AK + h * 64; d.v1 = U + tokb * USTR + U_AV + h * 64; d.ks1 = USTR; d.vs1 = USTR;
                d.out = YG + tok0 * DM + h * 64; d.sz = U + tok0 * USTR + U_AZ + h * 64;
            } else if (kind == 1) {
                d.q = QC + tok0 * 384 + h * 96; d.qs = 384;
                d.k0 = KCC + ((size_t)(layer * 4 + b) * 512) * KCS + h * 160; d.v0 = d.k0 + 96; d.ks0 = KCS; d.vs0 = KCS;
                d.k1 = KC + tokb * KCS + h * 160; d.v1 = d.k1 + 96; d.ks1 = KCS; d.vs1 = KCS;
                d.out = YG + tok0 * DM + 512 + h * 64; d.sz = U + tok0 * USTR + U_CZ + h * 64;
            } else {
                const int r = 4 * qb, rs = rstart(r), nloc = rstart(r + 3) + 8 - rs;
                d.q = U + tok0 * USTR + U_DQ + h * 64; d.qs = USTR;
                d.k0 = (const bf16_t*)(P.ws + WS_CDK) + crow0 * 256 + h * 64; d.v0 = (const bf16_t*)(P.ws + WS_CDV) + crow0 * 256 + h * 64; d.ks0 = 256; d.vs0 = 256;
                d.k1 = U + (tokb + rs * 64) * USTR + U_DK + h * 64; d.v1 = U + (tokb + rs * 64) * USTR + U_DV + h * 64; d.ks1 = USTR; d.vs1 = USTR; d.nt = 8 + nloc;
                d.out = YG + tok0 * DM + 768 + h * 64; d.sz = U + tok0 * USTR + U_DZ + h * 64;
                d.rpb = P.in[21] + (size_t)(layer * 4 + h) * 15 * 31; d.qrow0 = r; d.rs = rs;
            }
        } else {
            const int jj = item - 384, j = jj & 63, b = j >> 2, h = j & 3;
            kind = jj >> 6; panel = b;
            const size_t tokb = (size_t)b * 256, tok0 = tokb;
            d.nt0 = 4; d.nt = 4;
            if (kind == 0) {
                d.q = U + tok0 * USTR + U_AQ + h * 64; d.qs = USTR;
                d.k0 = U + tokb * USTR + U_AK + h * 64; d.v0 = U + tokb * USTR + U_AV + h * 64; d.ks0 = USTR; d.vs0 = USTR;
                d.out = YG + tok0 * DM + h * 64; d.sz = U + tok0 * USTR + U_AZ + h * 64;
            } else if (kind == 1) {
                d.q = QC + tok0 * 384 + h * 96; d.qs = 384;
                d.k0 = KC + tokb * KCS + h * 160; d.v0 = d.k0 + 96; d.ks0 = KCS; d.vs0 = KCS;
                d.out = YG + tok0 * DM + 512 + h * 64; d.sz = U + tok0 * USTR + U_CZ + h * 64;
            } else {
                d.q = U + tok0 * USTR + U_DQ + h * 64; d.qs = USTR;
                d.k0 = U + tokb * USTR + U_DK + h * 64; d.v0 = U + tokb * USTR + U_DV + h * 64; d.ks0 = USTR; d.vs0 = USTR;
                d.out = YG + tok0 * DM + 768 + h * 64; d.sz = U + tok0 * USTR + U_DZ + h * 64;
            }
        }
        if (kind == 0) {
            d.lam = lamp[0]; d.oml = 1.f - lamp[1]; d.subg = P.in[15] + layer * 64;
            if (!attn_unit<0, true>(d, lds, ctr, pend)) attn_unit<0, false>(d, lds, nullptr, nullptr);
        } else if (kind == 1) { if (!attn_unit<1, true>(d, lds, ctr, pend)) attn_unit<1, false>(d, lds, nullptr, nullptr); }
        else { if (!attn_unit<2, true>(d, lds, ctr, pend)) attn_unit<2, false>(d, lds, nullptr, nullptr); }
        pend = dep + panel;
    }
    return first_tail;
}

DI void phaseP2_tail(LAS unsigned char* lds, int layer, int phase_id, int item) {
#ifdef __HIP_DEVICE_COMPILE__
    typedef __attribute__((address_space(4))) const Params* KArgPtr;
    KArgPtr pp_ = (KArgPtr)__builtin_amdgcn_kernarg_segment_ptr();
    asm volatile("" : "+s"(pp_));
    Params P;
    __builtin_memcpy(&P, pp_, sizeof(Params));
#else
    Params P{};
#endif
    unsigned* ctr = (unsigned*)(P.ws + WS_CTL) + CW_QUEUE + 64 * phase_id;
    unsigned* dep = (unsigned*)(P.ws + WS_CTL) + CW_DEP + 64 * (phase_id & 31);
    LAS volatile int* sitem = (LAS volatile int*)(lds + LDS_CTLOFF + 16);
    const int nitems = P2_ITEMS + (layer + 1 < DEPTH ? LP_TOTAL : 0);
    for (;;) {
        if (item >= nitems) break;
        if (item >= P2_ITEMS) {
            int nx = 0;
            if (tidx() == 0) nx = (int)atomicAdd(ctr, 1u);
            layer_prep_item(P, lds, layer + 1, item - P2_ITEMS);
            __syncthreads();
            if (tidx() == 0) *sitem = nx;
        } else {
            const int idx = item - P2_ATT, pmi = idx >> 2, pm = pmi < 32 ? 16 + pmi : pmi - 32;
            dep_wait(dep + pm, 13u);
            pg8::Gemm g{(const bf16_t*)(P.ws + WS_YG), (const bf16_t*)(P.ws + WS_WOUT) + (size_t)layer * 1024 * 1024, NTOK, 1024, 1024, 0};
            unsigned* sig = (unsigned*)(P.ws + WS_CTL) + CW_DEP + 64 * ((phase_id & 31) + 1);
            if (layer + 1 < DEPTH) sig = nullptr;
            PQUnit S{pm, idx & 3, sig};
            EpiP3G E{&P, layer};
            pg8::gemm_phase<EpiP3G, PQUnit, true, true>(lds, g, S, E);
            if (tidx() == 0) *sitem = (int)atomicAdd(ctr, 1u);
        }
        __syncthreads();
        item = *sitem;
        __syncthreads();
    }
}

DI void phaseP3(const Params& P, LAS unsigned char* lds, int layer, int phase_id) {
    pg8::Gemm g{(const bf16_t*)(P.ws + WS_YG), (const bf16_t*)(P.ws + WS_WOUT) + (size_t)layer * 1024 * 1024, NTOK, 1024, 1024, 0};
    pg8::StaticOrder S; S.init(NTOK, 1024, (int)gridDim.x, bidx());
    EpiP3G E{&P, layer};
    pg8::gemm_phase<EpiP3G, pg8::StaticOrder, true, true>(lds, g, S, E);
    pg8::Unit u;
    if (!S.next(0, u) && layer + 1 < DEPTH) {
        const int nidle = (int)gridDim.x - 192;
        for (int it = bidx() - 192; it < LP_TOTAL; it += nidle) layer_prep_item(P, lds, layer + 1, it);
    }
    if (FUSE_N && S.next(0, u)) {
        unsigned* cnt = (unsigned*)(P.ws + WS_CTL) + CW_DEP + 64 * phase_id + u.pm;
        dep_signal(cnt);
        dep_wait(cnt, 4u);
        const int r0 = u.pm * 256 + u.pn * 64;
        if (layer + 1 < DEPTH) phaseN_rows(P, layer + 1, r0, r0 + 64, 32);
        else phaseFinal_rows(P, r0, r0 + 64, 32);
    }
}

#define XB_TMO      128
#define XB_XCNT(j)  (256  + 64 * (j))
#define XB_XSUB(j)  (1280 + 64 * (j))
#define XB_XGEN(j)  (2304 + 64 * (j))
#define XB_TOP      3328
#define XB_TOPGEN   3392
#define XCD_BAR_WORDS 3456
#define XB_SPIN_CAP (1u << 18)
DI unsigned xb_ld(unsigned* p) { return __hip_atomic_load(p, __ATOMIC_RELAXED, __HIP_MEMORY_SCOPE_AGENT); }
DI unsigned xb_add(unsigned* p, unsigned v) { return __hip_atomic_fetch_add(p, v, __ATOMIC_RELAXED, __HIP_MEMORY_SCOPE_AGENT); }
DI unsigned xb_xcc_id() { return (unsigned)__builtin_amdgcn_s_getreg((3 << 11) | 20) & 0xFu; }
#define XB_SPIN(cond, bar) do { unsigned _sp = 0; while (cond) { __builtin_amdgcn_s_sleep(1); \
    if ((++_sp & 255u) == 0u) { if (xb_ld(&(bar)[XB_TMO])) break; if (_sp > XB_SPIN_CAP) { atomicAdd(&(bar)[XB_TMO], 1u); break; } } } } while (0)
struct XcdBarrier { unsigned* bar; unsigned x; volatile LAS unsigned* st; };
DI XcdBarrier xcd_barrier_post(unsigned* bar, volatile LAS unsigned* st) {
    XcdBarrier b; b.bar = bar; b.x = xb_xcc_id(); b.st = st;
    if (tidx() == 0) (void)xb_add(&bar[XB_XCNT(b.x)], 1u);
    return b;
}
DI void xcd_barrier_complete(unsigned* bar, unsigned x, unsigned& nloc, unsigned& nx) {
    const unsigned G = gridDim.x * gridDim.y * gridDim.z;
    unsigned sum, cnt, mine, sp = 0u;
    for (;;) {
        sum = 0u; cnt = 0u; mine = 0u;
#pragma unroll
        for (unsigned j = 0; j < 16; ++j) { const unsigned c = xb_ld(&bar[XB_XCNT(j)]); sum += c; cnt += (c > 0u) ? 1u : 0u; }
        if (sum == G) { mine = xb_ld(&bar[XB_XCNT(x)]); break; }
        __builtin_amdgcn_s_sleep(1);
        if ((++sp & 255u) == 0u) { if (xb_ld(&bar[XB_TMO])) break; if (sp > XB_SPIN_CAP) { atomicAdd(&bar[XB_TMO], 1u); break; } }
    }
    nloc = mine > 0u ? mine : 1u; nx = cnt > 0u ? cnt : 1u;
}
DI void xcd_barrier(const XcdBarrier& b) {
    asm volatile("s_waitcnt vmcnt(0)" ::: "memory");
    __syncthreads();
    if (tidx() == 0) {
        unsigned* bar = b.bar;
        __builtin_amdgcn_s_waitcnt(0);
        unsigned nloc = b.st[0], nx = b.st[1];
        if (nloc == 0u) { xcd_barrier_complete(bar, b.x, nloc, nx); b.st[0] = nloc; b.st[1] = nx; }
        const unsigned old = xb_add(&bar[XB_XSUB(b.x)], 1u);
        const unsigned gen = old / nloc;
        if (old + 1u == (gen + 1u) * nloc) {
            __builtin_amdgcn_fence(__ATOMIC_RELEASE, "agent");
            asm volatile("s_waitcnt vmcnt(0)" ::: "memory");
            const unsigned og = xb_add(&bar[XB_TOP], 1u);
            const unsigned tg = og / nx;
            if (og + 1u == (tg + 1u) * nx) xb_add(&bar[XB_TOPGEN], 1u);
            else XB_SPIN(xb_ld(&bar[XB_TOPGEN]) == tg, bar);
            __builtin_amdgcn_fence(__ATOMIC_ACQUIRE, "agent");
            xb_add(&bar[XB_XGEN(b.x)], 1u);
            asm volatile("s_waitcnt vmcnt(0)" ::: "memory");
        } else {
            XB_SPIN(xb_ld(&bar[XB_XGEN(b.x)]) == gen, bar);
            __builtin_amdgcn_fence(__ATOMIC_ACQUIRE, "agent");
            asm volatile("s_waitcnt vmcnt(0)" ::: "memory");
        }
    }
    __syncthreads();
}
constexpr int CW_BAR = 8192;

__global__ void __launch_bounds__(NT, 2) hybrid_fwd(Params P0_) {
    extern __shared__ __attribute__((aligned(16))) unsigned char smem[];
    LAS unsigned char* lds = (LAS unsigned char*)smem;
#if MEGA
    volatile LAS unsigned* xst = (volatile LAS unsigned*)(lds + LDS_CTLOFF);
    if (tidx() == 0) { xst[0] = 0u; xst[1] = 0u; }
    __syncthreads();
    const XcdBarrier xbar = xcd_barrier_post((unsigned*)(P0_.ws + WS_CTL) + CW_BAR, xst);
#endif
    for (int phc = P0_.ph_lo; phc < P0_.ph_hi; ++phc) {
        int ph = phc;
        asm volatile("" : "+s"(ph));
#ifdef __HIP_DEVICE_COMPILE__
        typedef __attribute__((address_space(4))) const Params* KArgPtr;
        KArgPtr pp_ = (KArgPtr)__builtin_amdgcn_kernarg_segment_ptr();
        asm volatile("" : "+s"(pp_));
        Params P;
        __builtin_memcpy(&P, pp_, sizeof(Params));
#else
        const Params P = P0_;
#endif
#ifdef REPEAT
        for (int rep = 0; rep < 2; ++rep) {
#else
        const int rep = 0;
        {
#endif
            bool again = false;
            if (ph == 0) {
                phase0(P, lds);
                dep_wait((unsigned*)(P.ws + WS_CTL) + CW_DEP, 48u);
                phaseN_rows(P, 0, ((int)gridDim.x - 1 - bidx()) * 32, NTOK, gridDim.x * 32);
            }
            else if (ph == 1) { }
            else {
                const int layer = (ph - 2) / 3, sub = (ph - 2) % 3;
                if (sub == 0) { phaseP1(P, lds, layer, ph); }
                else if (sub == 1) { const int ft = phaseP2(P, lds, layer, ph + 32 * rep); phaseP2_tail(lds, layer, ph + 32 * rep, ft); again = (REPEAT_MASK & 16) != 0; }
                else {
                    if (layer + 1 < DEPTH) phaseN(P, layer + 1);
                    else {
                        unsigned* ndep = (unsigned*)(P.ws + WS_CTL) + CW_DEP + 64 * ph;
                        unsigned* fq = (unsigned*)(P.ws + WS_CTL) + CW_QUEUE + 64 * ph;
                        LAS volatile int* sitem = (LAS volatile int*)(lds + LDS_CTLOFF + 16);
                        if (tidx() == 0) *sitem = (int)atomicAdd(fq, 1u);
                        for (;;) {
                            __syncthreads();
                            const int q = *sitem;
                            __syncthreads();
                            if (q >= NTOK / 32) break;
                            int nx = 0;
                            if (tidx() == 0) nx = (int)atomicAdd(fq, 1u);
                            const int pmi = q >> 3, pm = pmi < 32 ? 16 + pmi : pmi - 32, r0 = pm * 256 + (q & 7) * 32;
                            dep_wait(ndep + pm, 4u);
                            phaseFinal_rows(P, r0, r0 + 32, 32);
                            if (tidx() == 0) *sitem = nx;
                        }
                    }
                }
            }
#ifdef REPEAT
            if (!again || rep == 1) break;
            xcd_barrier(xbar);
#endif
        }
#if MEGA
        if (ph + 1 < P0_.ph_hi && ph != 1 && ph != NPHASE - 2) xcd_barrier(xbar);
#ifdef DOUBLE_BAR
        if (ph + 1 < P0_.ph_hi) xcd_barrier(xbar);
#endif
#endif
    }
}

extern "C" void kernel_launch(void* const* d_in, const int* in_sizes, int n_in, void* d_out, int out_size, void* d_ws, size_t ws_size, hipStream_t stream) {
    static int grid_blocks = 0;
    if (grid_blocks == 0) {
        if (n_in != 24 || ws_size < WS_END) { fprintf(stderr, "kernel_launch: unexpected inputs (n_in %d, ws %zu)\n", n_in, ws_size); grid_blocks = -1; return; }
        int dev = 0, cus = 0, per_cu = 0;
        hipGetDevice(&dev);
        hipDeviceGetAttribute(&cus, hipDeviceAttributeMultiprocessorCount, dev);
        hipFuncSetAttribute((const void*)hybrid_fwd, hipFuncAttributeMaxDynamicSharedMemorySize, LDS_BYTES);
        hipOccupancyMaxActiveBlocksPerMultiprocessor(&per_cu, (const void*)hybrid_fwd, NT, LDS_BYTES);
        if (per_cu < 1) { fprintf(stderr, "kernel_launch: occupancy query says %d blocks per CU\n", per_cu); per_cu = 1; }
        if (per_cu > 1) per_cu = 1;
        grid_blocks = cus * per_cu;
        (void)hipGetLastError();
    }
    if (grid_blocks < 0) return;
    hipMemsetAsync((char*)d_ws + WS_CTL, 0, 65536, stream);
    Params p{};
    for (int i = 0; i < 24; ++i) p.in[i] = (const float*)d_in[i];
    p.out = (float*)d_out;
    p.ws = (unsigned char*)d_ws;
#if MEGA
    p.ph_lo = 0; p.ph_hi = NPHASE;
    void* args[] = {&p};
    hipError_t e = hipLaunchCooperativeKernel((const void*)hybrid_fwd, dim3(grid_blocks), dim3(NT), args, LDS_BYTES, stream);
    if (e != hipSuccess) fprintf(stderr, "cooperative launch failed: %s (grid %d)\n", hipGetErrorString(e), grid_blocks);
#else
    for (int ph = 0; ph < NPHASE; ++ph) {
        p.ph_lo = ph; p.ph_hi = ph + 1;
        hipLaunchKernelGGL(hybrid_fwd, dim3(grid_blocks), dim3(NT), LDS_BYTES, stream, p);
    }
#endif
}
```
